# Optimizing an MI355X kernel written in HIP

```python
import math
import jax, jax.numpy as jnp
from jax import lax
import numpy as np

D_MODEL = 1024
BATCH = 16
SEQ = 2048
DEPTH = 1

GLA_HEADS = 4
GLA_DK = D_MODEL // 2
GLA_DV = D_MODEL
GLA_HK = GLA_DK // GLA_HEADS
GLA_HV = GLA_DV // GLA_HEADS
GLA_RANK = 16
GLA_TAU = 16.0
GLA_CHUNK = 64
LOG_DECAY_FLOOR = -1.25

GMLP_WIDTH = D_MODEL
GMLP_GROUPS = 8
GMLP_GC = GMLP_WIDTH // GMLP_GROUPS
GMLP_CHUNK = 128

EPS = 1e-6

IN_SPLITS = (GLA_DK, GLA_DK, GLA_DV, GLA_DV, GLA_RANK, GLA_RANK,
             GMLP_WIDTH, GMLP_WIDTH, GMLP_WIDTH, D_MODEL, D_MODEL)
IN_WIDTH = sum(IN_SPLITS)

kernel_name = 'hybrid_gla_gmlp_adaln_block'


def _split_cols(p, sizes):
    outs = []
    off = 0
    for s in sizes:
        outs.append(p[..., off:off + s])
        off += s
    return outs


def _rmsnorm(x, g):
    xf = x.astype(jnp.float32)
    r = lax.rsqrt(jnp.mean(xf * xf, axis=-1, keepdims=True) + EPS)
    return (xf * r).astype(x.dtype) * g


def _layernorm(x, g, b):
    xf = x.astype(jnp.float32)
    mu = jnp.mean(xf, axis=-1, keepdims=True)
    var = jnp.mean(jnp.square(xf - mu), axis=-1, keepdims=True)
    return ((xf - mu) * lax.rsqrt(var + EPS)).astype(x.dtype) * g + b


def _gla_chunked(q, k, v, log_a, strict):
    B, H, S, dk = q.shape
    dv = v.shape[-1]
    C = GLA_CHUNK
    N = S // C
    q = q.reshape(B, H, N, C, dk)
    k = k.reshape(B, H, N, C, dk)
    v = v.reshape(B, H, N, C, dv)
    b = jnp.cumsum(log_a.reshape(B, H, N, C, dk), axis=3)
    b_last = b[:, :, :, -1:, :]
    q_t = q * jnp.exp(b)
    k_t = k * jnp.exp(-b)
    k_end = k * jnp.exp(b_last - b)
    mask = jnp.tril(jnp.ones((C, C), dtype=bool), k=-1 if strict else 0)
    attn = jnp.where(mask, jnp.einsum('bhntd,bhnsd->bhnts', q_t, k_t), 0.0)
    o_intra = jnp.einsum('bhnts,bhnsv->bhntv', attn, v)
    chunk_kv = jnp.einsum('bhnsd,bhnsv->bhndv', k_end, v)
    chunk_decay = jnp.exp(b_last[:, :, :, 0, :])

    def step(state, inp):
        d, kv = inp
        return d[..., None] * state + kv, state

    init = jnp.zeros((B, H, dk, dv), dtype=q.dtype)
    _, states = lax.scan(step, init, (jnp.moveaxis(chunk_decay, 2, 0), jnp.moveaxis(chunk_kv, 2, 0)))
    states = jnp.moveaxis(states, 0, 2)
    o_inter = jnp.einsum('bhntd,bhndv->bhntv', q_t, states)
    return (o_intra + o_inter).reshape(B, H, S, dv)


def _layer(x, c, norm_g, w_ada, b_ada, w_in, alpha_fw_w, alpha_fw_b, alpha_bw_w, alpha_bw_b,
           gla_norm_g, gmlp_ln_g, gmlp_ln_b, gmlp_ws, gmlp_bs, w_br_gla, w_br_gmlp, w_out):
    B, S, _ = x.shape
    mod = jax.nn.silu(c) @ w_ada + b_ada
    shift, scale, gate = jnp.split(mod, 3, axis=-1)
    h = _rmsnorm(x, norm_g) * (1.0 + scale[:, None, :]) + shift[:, None, :]

    p = h @ w_in
    (q, k, v, z_gla, ra_f, ra_b, u, vs, z_gmlp, m_gla, m_gmlp) = _split_cols(p, IN_SPLITS)

    def heads(t, hd):
        return t.reshape(B, S, GLA_HEADS, hd).transpose(0, 2, 1, 3).astype(jnp.float32)

    log_a_f = jnp.maximum(jax.nn.log_sigmoid(ra_f @ alpha_fw_w + alpha_fw_b) / GLA_TAU, LOG_DECAY_FLOOR)
    log_a_b = jnp.maximum(jax.nn.log_sigmoid(ra_b @ alpha_bw_w + alpha_bw_b) / GLA_TAU, LOG_DECAY_FLOOR)
    qh = heads(q, GLA_HK) * (GLA_HK ** -0.5)
    kh = heads(k, GLA_HK)
    vh = heads(v, GLA_HV)
    laf = heads(log_a_f, GLA_HK)
    lab = heads(log_a_b, GLA_HK)
    flip = lambda t: jnp.flip(t, axis=2)
    o_fw = _gla_chunked(qh, kh, vh, laf, strict=False)
    o_bw = flip(_gla_chunked(flip(qh), flip(kh), flip(vh), flip(lab), strict=True))
    o = o_fw + o_bw
    o = o * lax.rsqrt(jnp.mean(o * o, axis=-1, keepdims=True) + EPS) * gla_norm_g[None, :, None, :]
    o = o.transpose(0, 2, 1, 3).reshape(B, S, GLA_DV).astype(x.dtype)
    y_gla = (o * jax.nn.silu(z_gla)) @ w_br_gla

    u = jax.nn.gelu(u, approximate=False)
    vs = _layernorm(jax.nn.gelu(vs, approximate=False), gmlp_ln_g, gmlp_ln_b)
    vs = vs.reshape(B, S // GMLP_CHUNK, GMLP_CHUNK, GMLP_GROUPS, GMLP_GC)
    sg = jnp.einsum('gts,bnsgc->bntgc', gmlp_ws, vs) + gmlp_bs.T[None, None, :, :, None]
    sg = sg.reshape(B, S, GMLP_WIDTH)
    y_gmlp = (u * sg * jax.nn.silu(z_gmlp)) @ w_br_gmlp

    merged = jax.nn.sigmoid(m_gla) * y_gla + jax.nn.sigmoid(m_gmlp) * y_gmlp
    return x + gate[:, None, :] * (merged @ w_out)


def setup_inputs(seed: int = 0) -> dict:
    key = jax.random.key(seed)
    ks = jax.random.split(key, 20)
    D = D_MODEL
    nrm = lambda k, shape, s: jax.random.normal(k, shape, dtype=jnp.float32) * s
    return {
        'x': nrm(ks[0], (BATCH, SEQ, D), 1.0),
        'c': nrm(ks[1], (BATCH, D), 1.0),
        'norm_g': 1.0 + nrm(ks[2], (DEPTH, D), 0.02),
        'w_ada': nrm(ks[3], (DEPTH, D, 3 * D), 0.5 * D ** -0.5),
        'b_ada': nrm(ks[4], (DEPTH, 3 * D), 0.02),
        'w_in': nrm(ks[5], (DEPTH, D, IN_WIDTH), D ** -0.5),
        'alpha_fw_w': nrm(ks[6], (DEPTH, GLA_RANK, GLA_DK), GLA_RANK ** -0.5),
        'alpha_fw_b': nrm(ks[7], (DEPTH, GLA_DK), 0.1),
        'alpha_bw_w': nrm(ks[8], (DEPTH, GLA_RANK, GLA_DK), GLA_RANK ** -0.5),
        'alpha_bw_b': nrm(ks[9], (DEPTH, GLA_DK), 0.1),
        'gla_norm_g': 1.0 + nrm(ks[10], (DEPTH, GLA_HEADS, GLA_HV), 0.02),
        'gmlp_ln_g': 1.0 + nrm(ks[11], (DEPTH, GMLP_WIDTH), 0.02),
        'gmlp_ln_b': nrm(ks[12], (DEPTH, GMLP_WIDTH), 0.02),
        'gmlp_ws': nrm(ks[13], (DEPTH, GMLP_GROUPS, GMLP_CHUNK, GMLP_CHUNK), GMLP_CHUNK ** -0.5),
        'gmlp_bs': 1.0 + nrm(ks[14], (DEPTH, GMLP_GROUPS, GMLP_CHUNK), 0.02),
        'w_br_gla': nrm(ks[15], (DEPTH, GLA_DV, D), GLA_DV ** -0.5),
        'w_br_gmlp': nrm(ks[16], (DEPTH, GMLP_WIDTH, D), GMLP_WIDTH ** -0.5),
        'w_out': nrm(ks[17], (DEPTH, D, D), D ** -0.5),
        'final_g': 1.0 + nrm(ks[18], (D,), 0.02),
    }


def reference(x, c, norm_g, w_ada, b_ada, w_in, alpha_fw_w, alpha_fw_b, alpha_bw_w, alpha_bw_b,
              gla_norm_g, gmlp_ln_g, gmlp_ln_b, gmlp_ws, gmlp_bs, w_br_gla, w_br_gmlp, w_out, final_g):
    h = x
    for l in range(DEPTH):
        h = _layer(h, c, norm_g[l], w_ada[l], b_ada[l], w_in[l],
                   alpha_fw_w[l], alpha_fw_b[l], alpha_bw_w[l], alpha_bw_b[l],
                   gla_norm_g[l], gmlp_ln_g[l], gmlp_ln_b[l], gmlp_ws[l], gmlp_bs[l],
                   w_br_gla[l], w_br_gmlp[l], w_out[l])
    return _rmsnorm(h, final_g)
```

```cpp
#include <hip/hip_runtime.h>
#include <hip/hip_cooperative_groups.h>
#include <cstdio>
#include <cstdint>
namespace cg = cooperative_groups;
namespace pg8 {
#define PG8_LAS __attribute__((address_space(3)))
typedef unsigned short bf16_t;
typedef short bf16x8 __attribute__((ext_vector_type(8)));
typedef float f32x4 __attribute__((ext_vector_type(4)));
typedef unsigned u32x4 __attribute__((ext_vector_type(4)));
constexpr int BM = 256, BK = 64, HALF = 128, HTB = HALF * BK * 2  , STAGE_BYTES = 8 * HTB, NXCD = 8, WGM = 8;

__host__ __device__ __forceinline__ int lds_byte(int r, int c) { const int st = (r >> 4) * 2 + (c >> 5), rr = r & 15, cc = c & 31, ob = rr * 64 + cc * 2; return st * 1024 + (ob ^ (((ob >> 9) & 1) << 5)); }
__host__ __device__ __forceinline__ void stage_rc(int b, int& R, int& C) { const int st = b / 1024, sb = b % 1024, swz = sb ^ (((sb >> 9) & 1) << 5); R = (st >> 1) * 16 + swz / 64; C = (st & 1) * 32 + (swz % 64) / 2; }
__host__ __device__ __forceinline__ int perm32(int rho) { const int n = rho >> 4, i = rho & 15; return 8 * (i >> 2) + 4 * n + (i & 3); }

struct Unit { int pm, pn; };
struct Gemm { const bf16_t* A; const bf16_t* Bt; int M, N, K; };

struct StaticOrder {
    int nM, nN, nwg, G, c;
    __host__ __device__ void init(int M, int N, int G_, int c_) { nM = M / BM; nN = N / BM; nwg = nM * nN; G = G_; c = c_; }
    __host__ __device__ bool next(int i, Unit& u) const {
        const long L = (long)i * G + c; if (L >= nwg) return false;
        int wgid = (int)L; { const int q = nwg / NXCD, r = nwg % NXCD, xcd = wgid % NXCD, off = wgid / NXCD; wgid = (xcd < r ? xcd * (q + 1) : r * (q + 1) + (xcd - r) * q) + off; }
        const int nig = WGM * nN, gid = wgid / nig, fm = gid * WGM, gsz = (nM - fm) < WGM ? (nM - fm) : WGM;
        u.pm = fm + ((wgid % nig) % gsz); u.pn = (wgid % nig) / gsz; return true;
    }
    __device__ __forceinline__ void a_ready(const Unit&) const {}
    __device__ __forceinline__ void done(const Unit&) const {}
};

typedef float f32x2c_t __attribute__((ext_vector_type(2)));
typedef __bf16 bf16x2c_t __attribute__((ext_vector_type(2)));
__device__ __forceinline__ unsigned cvt_pk_bf16(float lo, float hi) { const f32x2c_t v = {lo, hi}; const bf16x2c_t b = __builtin_convertvector(v, bf16x2c_t); return __builtin_bit_cast(unsigned, b); }
typedef float f32x2 __attribute__((ext_vector_type(2)));
__device__ __forceinline__ f32x2 gelu_pk(f32x2 v) {
    const f32x2 av = __builtin_elementwise_abs(v), d = av * 0.2316418882f + 1.0f;
    f32x2 t; t.x = __builtin_amdgcn_rcpf(d.x); t.y = __builtin_amdgcn_rcpf(d.y);
    f32x2 q = t * 0.5307027145f + (-0.7265760135f); q = q * t + 0.7107068705f; q = q * t + (-0.142248368f); q = q * t + 0.127414796f; q = q * t;
    const f32x2 s = (v * v) * (-0.72134752044f);
    f32x2 e; e.x = __builtin_amdgcn_exp2f(s.x); e.y = __builtin_amdgcn_exp2f(s.y);
    const f32x2 m = v * (q * e), r = v - m;
    f32x2 o; o.x = v.x < 0.f ? m.x : r.x; o.y = v.y < 0.f ? m.y : r.y; return o;
}

template <class Epi, class Sched, bool ALIGN_EPI = false, bool SP2 = false>
__device__ __forceinline__ void gemm_phase(PG8_LAS unsigned char* lds, const Gemm g, const Sched& S, const Epi& E) {
    const int tid = threadIdx.x, wid = __builtin_amdgcn_readfirstlane(tid >> 6), lane = tid & 63, wr = wid >> 2, wc = wid & 3, fr = lane & 15, fq = lane >> 4;
    const int K = g.K, nt = K / BK;
    unsigned voffA[2], voffB[2];
#pragma unroll
    for (int i = 0; i < 2; ++i) { int R, C; stage_rc(tid * 16 + i * 8192, R, C); const int Rb = Epi::PERM ? ((R & ~31) + perm32(R & 31)) : R;
        voffA[i] = (unsigned)(R * K + C) * 2u; voffB[i] = (unsigned)(Rb * K + C) * 2u; }
    const size_t kstep = (size_t)(BK * 2);
    const size_t hstep = (size_t)HALF * K * 2;
    const size_t tstep = 2 * hstep;
    const unsigned ldsw = (unsigned)wid * 1024u;
    const int aoff = lds_byte(wr * 64 + fr, fq * 8), boff = lds_byte(wc * 32 + fr, fq * 8);
#define PG8_SA(b, h) (((b) * 2 + (h)) * HTB)
#define PG8_SB(b, h) ((4 + (b) * 2 + (h)) * HTB)
#define PG8_STAGE(bufoff, gbase, voff) do { _Pragma("unroll") for (int _i = 0; _i < 2; ++_i) \
        __builtin_amdgcn_global_load_lds((const unsigned*)((const char*)(gbase) + (voff)[_i]), (PG8_LAS unsigned*)(lds + (bufoff) + ldsw + _i * 8192), 16, 0, 0); } while (0)
#define PG8_LDA(dst, b, h) do { _Pragma("unroll") for (int m = 0; m < 4; ++m) _Pragma("unroll") for (int k = 0; k < 2; ++k) dst[m][k] = *(const PG8_LAS bf16x8*)(lds + PG8_SA(b, h) + aoff + m * 2048 + k * 1024); } while (0)
#define PG8_LDB(dst, b, h) do { _Pragma("unroll") for (int n = 0; n < 2; ++n) _Pragma("unroll") for (int k = 0; k < 2; ++k) dst[n][k] = *(const PG8_LAS bf16x8*)(lds + PG8_SB(b, h) + boff + n * 2048 + k * 1024); } while (0)
#define PG8_MMA(ai, bj, At, Bt) do { __builtin_amdgcn_s_setprio(1); _Pragma("unroll") for (int m = 0; m < 4; ++m) _Pragma("unroll") for (int n = 0; n < 2; ++n) _Pragma("unroll") for (int k = 0; k < 2; ++k) \
        acc[ai][bj][m][n] = __builtin_amdgcn_mfma_f32_16x16x32_bf16(Bt[n][k], At[m][k], acc[ai][bj][m][n], 0, 0, 0); __builtin_amdgcn_s_setprio(0); } while (0)
#define PG8_WAIT_V(n) asm volatile("s_waitcnt vmcnt(" #n ")" ::: "memory")
#define PG8_WAIT_L(n) asm volatile("s_waitcnt lgkmcnt(" #n ")" ::: "memory")
#define PG8_BAR __builtin_amdgcn_s_barrier()
#define PG8_SCHED __builtin_amdgcn_sched_barrier(0)
    Unit cur, nxt; int ui = 0;
    if (!S.next(0, cur)) return;
    f32x4 acc[2][2][4][2];
#pragma unroll
    for (int a = 0; a < 2; ++a)
#pragma unroll
        for (int b = 0; b < 2; ++b)
#pragma unroll
            for (int m = 0; m < 4; ++m)
#pragma unroll
                for (int n = 0; n < 2; ++n) acc[a][b][m][n] = (f32x4){0.f, 0.f, 0.f, 0.f};
    bf16x8 At[4][2], B0[2][2], B1[2][2];
    const char* cA = (const char*)g.A + (size_t)cur.pm * tstep; const char* cB = (const char*)g.Bt + (size_t)cur.pn * tstep;
    S.a_ready(cur);
    if constexpr (SP2) {
        PG8_STAGE(PG8_SB(0, 0), cB, voffB); PG8_STAGE(PG8_SB(0, 1), cB + hstep, voffB); PG8_STAGE(PG8_SA(0, 0), cA, voffA); PG8_STAGE(PG8_SA(0, 1), cA + hstep, voffA);
        if (wr == 1) PG8_BAR;
        PG8_WAIT_V(2); PG8_BAR;
        PG8_STAGE(PG8_SB(1, 0), cB + kstep, voffB); PG8_STAGE(PG8_SA(1, 0), cA + kstep, voffA); PG8_STAGE(PG8_SB(1, 1), cB + hstep + kstep, voffB);
        PG8_WAIT_V(6); PG8_BAR;
    } else {
        PG8_STAGE(PG8_SB(0, 0), cB, voffB); PG8_STAGE(PG8_SA(0, 0), cA, voffA); PG8_STAGE(PG8_SB(0, 1), cB + hstep, voffB); PG8_STAGE(PG8_SA(0, 1), cA + hstep, voffA);
        if (wr == 1) PG8_BAR;
        PG8_WAIT_V(4); PG8_BAR;
        PG8_STAGE(PG8_SB(1, 0), cB + kstep, voffB); PG8_STAGE(PG8_SA(1, 0), cA + kstep, voffA); PG8_STAGE(PG8_SB(1, 1), cB + hstep + kstep, voffB);
        PG8_WAIT_V(6); PG8_BAR;
    }
    for (;;) {
        const bool has_next = S.next(ui + 1, nxt);
        const char* nA = has_next ? (const char*)g.A + (size_t)nxt.pm * tstep : cA; const char* nB = has_next ? (const char*)g.Bt + (size_t)nxt.pn * tstep : cB;
        for (int t = 0; t < nt; t += 2) {
            const bool last = (t == nt - 2);
            const char* a1 = cA + (size_t)(t + 1) * kstep;
            const char* a2 = last ? nA : cA + (size_t)(t + 2) * kstep; const char* b2 = last ? nB : cB + (size_t)(t + 2) * kstep;
            const char* a3 = a2 + kstep; const char* b3 = b2 + kstep;
            if (last && has_next) S.a_ready(nxt);
            if constexpr (SP2) {
            PG8_LDB(B0, 0, 0); PG8_LDB(B1, 0, 1); PG8_SCHED; PG8_LDA(At, 0, 0); PG8_STAGE(PG8_SA(1, 1), a1 + hstep, voffA);
            PG8_WAIT_V(8); PG8_WAIT_L(0); PG8_BAR; PG8_MMA(0, 0, At, B0); PG8_MMA(0, 1, At, B1); PG8_BAR; PG8_SCHED;
            PG8_LDA(At, 0, 1); PG8_STAGE(PG8_SB(0, 0), b2, voffB); PG8_STAGE(PG8_SB(0, 1), b2 + hstep, voffB); PG8_STAGE(PG8_SA(0, 0), a2, voffA);
            PG8_WAIT_V(8); PG8_WAIT_L(0); PG8_BAR; PG8_MMA(1, 0, At, B0); PG8_MMA(1, 1, At, B1); PG8_BAR; PG8_SCHED;
            PG8_LDB(B0, 1, 0); PG8_LDB(B1, 1, 1); PG8_SCHED; PG8_LDA(At, 1, 0); PG8_STAGE(PG8_SA(0, 1), a2 + hstep, voffA);
            PG8_WAIT_V(8); PG8_WAIT_L(0); PG8_BAR; PG8_MMA(0, 0, At, B0); PG8_MMA(0, 1, At, B1); PG8_BAR; PG8_SCHED;
            PG8_LDA(At, 1, 1); PG8_STAGE(PG8_SB(1, 0), b3, voffB); PG8_STAGE(PG8_SB(1, 1), b3 + hstep, voffB); PG8_STAGE(PG8_SA(1, 0), a3, voffA);
            PG8_WAIT_V(8); PG8_WAIT_L(0); PG8_BAR; PG8_MMA(1, 0, At, B0); PG8_MMA(1, 1, At, B1); PG8_BAR; PG8_SCHED;
            } else {
            PG8_LDB(B0, 0, 0); PG8_SCHED; PG8_LDA(At, 0, 0); PG8_STAGE(PG8_SA(1, 1), a1 + hstep, voffA);
            PG8_WAIT_L(8); PG8_BAR; PG8_WAIT_L(0); PG8_MMA(0, 0, At, B0); PG8_BAR; PG8_SCHED;
            PG8_LDB(B1, 0, 1); PG8_STAGE(PG8_SB(0, 0), b2, voffB);
            PG8_BAR; PG8_WAIT_L(0); PG8_MMA(0, 1, At, B1); PG8_BAR;
            PG8_LDA(At, 0, 1); PG8_STAGE(PG8_SA(0, 0), a2, voffA);
            PG8_BAR; PG8_WAIT_L(0); PG8_MMA(1, 0, At, B0); PG8_BAR; PG8_SCHED;
            PG8_STAGE(PG8_SB(0, 1), b2 + hstep, voffB);
            PG8_WAIT_V(6); PG8_BAR; PG8_MMA(1, 1, At, B1); PG8_BAR;
            PG8_LDB(B0, 1, 0); PG8_SCHED; PG8_LDA(At, 1, 0); PG8_STAGE(PG8_SA(0, 1), a2 + hstep, voffA);
            PG8_WAIT_L(8); PG8_BAR; PG8_WAIT_L(0); PG8_MMA(0, 0, At, B0); PG8_BAR; PG8_SCHED;
            PG8_LDB(B1, 1, 1); PG8_STAGE(PG8_SB(1, 0), b3, voffB);
            PG8_BAR; PG8_WAIT_L(0); PG8_MMA(0, 1, At, B1); PG8_BAR;
            PG8_LDA(At, 1, 1); PG8_STAGE(PG8_SA(1, 0), a3, voffA);
            PG8_BAR; PG8_WAIT_L(0); PG8_MMA(1, 0, At, B0); PG8_BAR; PG8_SCHED;
            PG8_STAGE(PG8_SB(1, 1), b3 + hstep, voffB);
            PG8_WAIT_V(6); PG8_BAR; PG8_MMA(1, 1, At, B1); PG8_BAR;
            }
        }
        if constexpr (ALIGN_EPI) { if (wr == 0) PG8_BAR; }
        if constexpr (!Epi::AFTER_DRAIN) { E(acc, cur, wr, wc, fr, fq); S.done(cur); }
        if (!has_next) break;
#pragma unroll
        for (int a = 0; a < 2; ++a)
#pragma unroll
            for (int b = 0; b < 2; ++b)
#pragma unroll
                for (int m = 0; m < 4; ++m)
#pragma unroll
                    for (int n = 0; n < 2; ++n) acc[a][b][m][n] = (f32x4){0.f, 0.f, 0.f, 0.f};
        cur = nxt; cA = nA; cB = nB; ++ui;
        if constexpr (ALIGN_EPI) { if (wr == 1) PG8_BAR; }
    }
    PG8_WAIT_V(0);
    if constexpr (!ALIGN_EPI) { if (wr == 0) PG8_BAR; }
    PG8_BAR;
    if constexpr (Epi::AFTER_DRAIN) { E.fused(acc, cur, wr, wc, fr, fq, lds, wid, lane); S.done(cur); }
#undef PG8_SA
#undef PG8_SB
#undef PG8_STAGE
#undef PG8_LDA
#undef PG8_LDB
#undef PG8_MMA
#undef PG8_WAIT_V
#undef PG8_WAIT_L
#undef PG8_BAR
#undef PG8_SCHED
}
__device__ __forceinline__ float fsigmoid(float x) { return __builtin_amdgcn_rcpf(1.0f + __expf(-x)); }
__device__ __forceinline__ float fsilu(float x) { return x * fsigmoid(x); }
__device__ __forceinline__ f32x4 gelu4(f32x4 v) { const f32x2 a = gelu_pk((f32x2){v[0], v[1]}), b = gelu_pk((f32x2){v[2], v[3]}); return (f32x4){a.x, a.y, b.x, b.y}; }
__device__ __forceinline__ f32x4 silu4(f32x4 v) { return (f32x4){fsilu(v[0]), fsilu(v[1]), fsilu(v[2]), fsilu(v[3])}; }
__device__ __forceinline__ f32x4 sigm4(f32x4 v) { return (f32x4){fsigmoid(v[0]), fsigmoid(v[1]), fsigmoid(v[2]), fsigmoid(v[3])}; }
__device__ __forceinline__ f32x4 act4(int act, f32x4 v, float sc) {
    if (act == 0) return v * sc;
    if (act == 1) return silu4(v);
    if (act == 2) return gelu4(v);
    return sigm4(v);
}
__device__ __forceinline__ u32x4 pack8(f32x4 v0, f32x4 v1) { u32x4 w; w.x = cvt_pk_bf16(v0[0], v0[1]); w.y = cvt_pk_bf16(v0[2], v0[3]); w.z = cvt_pk_bf16(v1[0], v1[1]); w.w = cvt_pk_bf16(v1[2], v1[3]); return w; }
__device__ __forceinline__ float bf_lo(unsigned w) { return __uint_as_float(w << 16); }
__device__ __forceinline__ float bf_hi(unsigned w) { return __uint_as_float(w & 0xffff0000u); }

struct EpiIn {
    static constexpr bool PERM = true, AFTER_DRAIN = false;
    bf16_t *q, *k, *v, *sz, *ug, *gv, *smg, *smm; float* ra;
    __device__ __forceinline__ void operator()(const f32x4 (&acc)[2][2][4][2], const Unit& u, int wr, int wc, int fr, int fq) const {
        const int pn = u.pn, row0 = u.pm * BM + wr * 64 + fr, cw = wc * 32 + 8 * fq;
        if (pn == 32) {
            if (wc == 0) {
#pragma unroll
                for (int ai = 0; ai < 2; ++ai)
#pragma unroll
                    for (int m = 0; m < 4; ++m) { float* rp = ra + (size_t)(row0 + ai * HALF + m * 16) * 32 + 8 * fq; *(f32x4*)rp = acc[ai][0][m][0]; *(f32x4*)(rp + 4) = acc[ai][0][m][1]; }
            }
            return;
        }
        if (pn >= 12 && pn < 20) {
            const int T = pn - 12;
#pragma unroll
            for (int ai = 0; ai < 2; ++ai)
#pragma unroll
                for (int m = 0; m < 4; ++m) { bf16_t* rp = ug + (size_t)(row0 + ai * HALF + m * 16) * 1024 + 128 * T + cw;
                    const f32x4 a0 = gelu4(acc[ai][0][m][0]) * silu4(acc[ai][1][m][0]), a1 = gelu4(acc[ai][0][m][1]) * silu4(acc[ai][1][m][1]);
                    *(u32x4*)rp = pack8(a0, a1); }
            return;
        }
        bf16_t* base; int ld = 1024, colt, act; float sc = 1.f;
        if (pn < 2) { base = q; ld = 512; colt = pn * 256; act = 0; sc = 0.08838834764831845f; }
        else if (pn < 4) { base = k; ld = 512; colt = (pn - 2) * 256; act = 0; }
        else if (pn < 8) { base = v; colt = (pn - 4) * 256; act = 0; }
        else if (pn < 12) { base = sz; colt = (pn - 8) * 256; act = 1; }
        else if (pn < 24) { base = gv; colt = (pn - 20) * 256; act = 2; }
        else if (pn < 28) { base = smg; colt = (pn - 24) * 256; act = 3; }
        else { base = smm; colt = (pn - 28) * 256; act = 3; }
#pragma unroll
        for (int ai = 0; ai < 2; ++ai)
#pragma unroll
            for (int m = 0; m < 4; ++m) { bf16_t* rp = base + (size_t)(row0 + ai * HALF + m * 16) * ld + colt + cw;
#pragma unroll
                for (int bj = 0; bj < 2; ++bj) *(u32x4*)(rp + bj * HALF) = pack8(act4(act, acc[ai][bj][m][0], sc), act4(act, acc[ai][bj][m][1], sc)); }
    }
};
template <bool FIRST> struct EpiMerge {
    static constexpr bool PERM = true, AFTER_DRAIN = false;
    const bf16_t* gate; bf16_t* mg;
    __device__ __forceinline__ void operator()(const f32x4 (&acc)[2][2][4][2], const Unit& u, int wr, int wc, int fr, int fq) const {
        const int row0 = u.pm * BM + wr * 64 + fr, c0 = u.pn * BM + wc * 32 + 8 * fq;
#pragma unroll
        for (int ai = 0; ai < 2; ++ai)
#pragma unroll
            for (int m = 0; m < 4; ++m)
#pragma unroll
                for (int bj = 0; bj < 2; ++bj) { const size_t off = (size_t)(row0 + ai * HALF + m * 16) * 1024 + c0 + bj * HALF;
                    const u32x4 g = *(const u32x4*)(gate + off);
                    f32x4 v0 = acc[ai][bj][m][0] * (f32x4){bf_lo(g.x), bf_hi(g.x), bf_lo(g.y), bf_hi(g.y)}, v1 = acc[ai][bj][m][1] * (f32x4){bf_lo(g.z), bf_hi(g.z), bf_lo(g.w), bf_hi(g.w)};
                    if (!FIRST) { const u32x4 p = *(const u32x4*)(mg + off); v0 += (f32x4){bf_lo(p.x), bf_hi(p.x), bf_lo(p.y), bf_hi(p.y)}; v1 += (f32x4){bf_lo(p.z), bf_hi(p.z), bf_lo(p.w), bf_hi(p.w)}; }
                    *(u32x4*)(mg + off) = pack8(v0, v1); }
    }
};
struct EpiOut {
    static constexpr bool PERM = false, AFTER_DRAIN = false;
    const float* x; const float* gate; float* out;
    __device__ __forceinline__ void operator()(const f32x4 (&acc)[2][2][4][2], const Unit& u, int wr, int wc, int fr, int fq) const {
        const int row0 = u.pm * BM + wr * 64 + fr, c0 = u.pn * BM + wc * 32 + 4 * fq;
#pragma unroll
        for (int ai = 0; ai < 2; ++ai)
#pragma unroll
            for (int m = 0; m < 4; ++m) { const int row = row0 + ai * HALF + m * 16; const float* gp = gate + (size_t)(row >> 11) * 3072;
#pragma unroll
                for (int bj = 0; bj < 2; ++bj)
#pragma unroll
                    for (int n = 0; n < 2; ++n) { const int c = c0 + bj * HALF + 16 * n; const size_t off = (size_t)row * 1024 + c;
                        *(f32x4*)(out + off) = *(const f32x4*)(x + off) + *(const f32x4*)(gp + c) * acc[ai][bj][m][n]; } }
    }
};
}

#ifndef PG8_SP2
#define PG8_SP2 true
#endif
#ifndef PG8_ALIGN
#define PG8_ALIGN true
#endif
#define LAS __attribute__((address_space(3)))
typedef unsigned short bf16;
typedef float f32x4 __attribute__((ext_vector_type(4)));
typedef short bf16x8 __attribute__((ext_vector_type(8)));
typedef unsigned u32x4 __attribute__((ext_vector_type(4)));
typedef unsigned u32x2 __attribute__((ext_vector_type(2)));
constexpr int NWAVES = 8, NTHR = 512;
constexpr int D = 1024, NB = 16, S = 2048, M = NB * S, NINP = 8448  , NIN_SRC = 8224;
constexpr float EPS = 1e-6f;
constexpr size_t MiB = 1u << 20;
constexpr size_t WS_MOD = 1 * MiB;
constexpr size_t WS_WIN = 2 * MiB, WS_WG = 19 * MiB, WS_WM = 21 * MiB, WS_WO = 23 * MiB;
constexpr size_t WS_RA = 26 * MiB;
constexpr size_t WS_Q = 32 * MiB, WS_K = 64 * MiB, WS_V = 96 * MiB, WS_SZ = 160 * MiB, WS_UG = 224 * MiB, WS_GV = 288 * MiB, WS_SMG = 352 * MiB, WS_SMM = 416 * MiB, WS_END = 480 * MiB;
constexpr size_t WS_MG = WS_Q;
constexpr int LDS_BYTES = 147456;

__device__ __forceinline__ unsigned pk2(float lo, float hi) { return pg8::cvt_pk_bf16(lo, hi); }
__device__ __forceinline__ float bf_lo(unsigned w) { return __uint_as_float(w << 16); }
__device__ __forceinline__ float bf_hi(unsigned w) { return __uint_as_float(w & 0xffff0000u); }
__device__ __forceinline__ float bf2f(unsigned short h) { return __uint_as_float((unsigned)h << 16); }
__device__ __forceinline__ unsigned short f2bf(float f) { return (unsigned short)(pk2(f, 0.f) & 0xffffu); }
__device__ __forceinline__ float wave_sum(float v) {
#pragma unroll
    for (int o = 1; o < 64; o <<= 1) v += __shfl_xor(v, o);
    return v;
}
#define MFMA16(a, b, c) __builtin_amdgcn_mfma_f32_16x16x32_bf16((a), (b), (c), 0, 0, 0)

__device__ __forceinline__ void p0_mod(LAS unsigned char* lds, const float* c, const float* w_ada, const float* b_ada, float* mod, int blk, int tid) {
    LAS float* sc = (LAS float*)lds;
    LAS float* red = (LAS float*)(lds + 65536);
    for (int i = tid; i < NB * D; i += NTHR) { const float v = c[i]; sc[i] = v / (1.0f + __expf(-v)); }
    __syncthreads();
    const int wave = tid >> 6, lane = tid & 63, col = 64 * blk + lane;
    float acc[16];
#pragma unroll
    for (int b = 0; b < 16; ++b) acc[b] = 0.f;
    for (int kk = 0; kk < 128; ++kk) { const int k = wave * 128 + kk; const float w = w_ada[(size_t)k * 3072 + col];
#pragma unroll
        for (int b = 0; b < 16; ++b) acc[b] += sc[b * D + k] * w; }
#pragma unroll
    for (int b = 0; b < 16; ++b) red[(wave * 16 + b) * 64 + lane] = acc[b];
    __syncthreads();
    for (int o = tid; o < 1024; o += NTHR) { const int b = o >> 6, l = o & 63; float s = b_ada[64 * blk + l];
#pragma unroll
        for (int w = 0; w < 8; ++w) s += red[(w * 16 + b) * 64 + l];
        mod[(size_t)b * 3072 + 64 * blk + l] = s; }
    __syncthreads();
}
__device__ __forceinline__ void transpose_item(const float* W, int Nsrc, bf16* WT, int K, int dst_row0, int src_col0, int k0, LAS float* scr, int lane) {
    if (src_col0 >= 0) {
#pragma unroll 8
        for (int i = 0; i < 32; ++i) { const int kk = 2 * i + (lane >> 5); scr[kk * 33 + (lane & 31)] = W[(size_t)(k0 + kk) * Nsrc + src_col0 + (lane & 31)]; }
    } else {
#pragma unroll 8
        for (int i = 0; i < 32; ++i) { const int kk = 2 * i + (lane >> 5); scr[kk * 33 + (lane & 31)] = 0.f; }
    }
    asm volatile("s_waitcnt vmcnt(0) lgkmcnt(0)" ::: "memory");
    const int c = lane & 7;
#pragma unroll
    for (int j = 0; j < 4; ++j) { const int n = (lane >> 3) + 8 * j; const LAS float* s = scr + (8 * c) * 33 + n;
        u32x4 o; o.x = pk2(s[0 * 33], s[1 * 33]); o.y = pk2(s[2 * 33], s[3 * 33]); o.z = pk2(s[4 * 33], s[5 * 33]); o.w = pk2(s[6 * 33], s[7 * 33]);
        *(u32x4*)(WT + (size_t)(dst_row0 + n) * K + k0 + 8 * c) = o; }
    asm volatile("s_waitcnt lgkmcnt(0)" ::: "memory");
}
__device__ __forceinline__ int win_src_block(int db) {
    if (db < 96) return db;
    if (db < 160) { const int T = (db - 96) >> 3, r = (db - 96) & 7; return r < 4 ? 97 + 4 * T + r : 161 + 4 * T + (r - 4); }
    if (db < 192) return 129 + (db - 160);
    if (db < 224) return 193 + (db - 192);
    if (db < 256) return 225 + (db - 224);
    if (db == 256) return 96;
    return -1;
}

struct Args {
    const float* in[19]; float* out; unsigned char* ws;
};

constexpr int G_Q = 0, G_K = 17408, G_KE = 34816, G_VT = 53248, G_P = 71680, G_ST = 80896, G_RA = 115712, G_EBL = 119808, G_CS = 120320, G_END = 122368;
static_assert(G_END <= LDS_BYTES, "GLA LDS map");
__device__ __forceinline__ void gla_item(LAS unsigned char* lds, const bf16* __restrict__ qb, const bf16* __restrict__ kb, const bf16* __restrict__ vb, const float* __restrict__ rab,
                                         const float* __restrict__ aw_p, const float* __restrict__ ab_p, bf16* __restrict__ ob, int b, int h, int dir, int vh, int tid) {
    const int lane = tid & 63, wave = __builtin_amdgcn_readfirstlane(tid >> 6), l15 = lane & 15, lg = lane >> 4;
    const int d = tid & 127, tq = tid >> 7;
    float aw[16];
#pragma unroll
    for (int r = 0; r < 16; ++r) aw[r] = aw_p[r * 512 + h * 128 + d];
    const float ab = ab_p[h * 128 + d];
    f32x4 st[8];
#pragma unroll
    for (int i = 0; i < 8; ++i) st[i] = (f32x4){0.f, 0.f, 0.f, 0.f};
    for (int i = tid; i < 34816 / 16; i += NTHR) *(LAS u32x4*)(lds + G_ST + i * 16) = (u32x4){0u, 0u, 0u, 0u};
    u32x4 rq[2], rk[2], rv[2]; f32x4 rr = (f32x4){0.f, 0.f, 0.f, 0.f};
    const size_t tokb = (size_t)b * S;
#define GLA_TOK(n, r) (tokb + (size_t)(dir ? (S - 1 - (64 * (n) + (r))) : (64 * (n) + (r))))
#define GLA_LOAD(n) do { \
        _Pragma("unroll") for (int i = 0; i < 2; ++i) { const int p = tid + 512 * i, row = p >> 4, c8 = p & 15; const size_t tok = GLA_TOK(n, row); \
            rq[i] = *(const u32x4*)(qb + tok * 512 + h * 128 + c8 * 8); rk[i] = *(const u32x4*)(kb + tok * 512 + h * 128 + c8 * 8); } \
        _Pragma("unroll") for (int i = 0; i < 2; ++i) { const int s = tid & 63, c8 = (tid >> 6) + 8 * i; const size_t tok = GLA_TOK(n, s); \
            rv[i] = *(const u32x4*)(vb + tok * 1024 + h * 256 + vh * 128 + c8 * 8); } \
        if (tid < 256) { const int row = tid >> 2, part = tid & 3; rr = *(const f32x4*)(rab + GLA_TOK(n, row) * 32 + dir * 16 + part * 4); } } while (0)
    GLA_LOAD(0);
    for (int n = 0; n < 32; ++n) {
#pragma unroll
        for (int i = 0; i < 2; ++i) { const int p = tid + 512 * i, row = p >> 4, c8 = p & 15;
            *(LAS u32x4*)(lds + G_Q + row * 272 + c8 * 16) = rq[i]; *(LAS u32x4*)(lds + G_K + row * 272 + c8 * 16) = rk[i]; }
#pragma unroll
        for (int i = 0; i < 2; ++i) { const int s = tid & 63, c8 = (tid >> 6) + 8 * i; LAS unsigned short* vt = (LAS unsigned short*)(lds + G_VT + (c8 * 8) * 144 + 2 * s);
            vt[0 * 72] = (unsigned short)(rv[i].x & 0xffffu); vt[1 * 72] = (unsigned short)(rv[i].x >> 16); vt[2 * 72] = (unsigned short)(rv[i].y & 0xffffu); vt[3 * 72] = (unsigned short)(rv[i].y >> 16);
            vt[4 * 72] = (unsigned short)(rv[i].z & 0xffffu); vt[5 * 72] = (unsigned short)(rv[i].z >> 16); vt[6 * 72] = (unsigned short)(rv[i].w & 0xffffu); vt[7 * 72] = (unsigned short)(rv[i].w >> 16); }
        if (tid < 256) { const int row = tid >> 2, part = tid & 3; *(LAS f32x4*)(lds + G_RA + (row * 16 + part * 4) * 4) = rr; }
        if (n + 1 < 32) GLA_LOAD(n + 1);
        __syncthreads();
        float bl[16]; float run = 0.f;
#pragma unroll
        for (int i = 0; i < 16; ++i) { const int jj = 16 * tq + i; const LAS f32x4* rp = (const LAS f32x4*)(lds + G_RA + jj * 64);
            const f32x4 r0 = rp[0], r1 = rp[1], r2 = rp[2], r3 = rp[3];
            float z = ab;
            z += r0[0] * aw[0]; z += r0[1] * aw[1]; z += r0[2] * aw[2]; z += r0[3] * aw[3]; z += r1[0] * aw[4]; z += r1[1] * aw[5]; z += r1[2] * aw[6]; z += r1[3] * aw[7];
            z += r2[0] * aw[8]; z += r2[1] * aw[9]; z += r2[2] * aw[10]; z += r2[3] * aw[11]; z += r3[0] * aw[12]; z += r3[1] * aw[13]; z += r3[2] * aw[14]; z += r3[3] * aw[15];
            const float ls = fminf(z, 0.f) - __logf(1.0f + __expf(-fabsf(z)));
            run += fmaxf(ls * 0.0625f, -1.25f); bl[i] = run; }
        ((LAS float*)(lds + G_CS))[tq * 128 + d] = run;
        __syncthreads();
        { const LAS float* cs = (const LAS float*)(lds + G_CS); const float c0 = cs[d], c1 = cs[128 + d], c2 = cs[256 + d], c3 = cs[384 + d];
          const float prefix = (tq > 0 ? c0 : 0.f) + (tq > 1 ? c1 : 0.f) + (tq > 2 ? c2 : 0.f), blast = (c0 + c1) + (c2 + c3);
          unsigned kew[8];
#pragma unroll
          for (int i = 0; i < 16; i += 2) {
              float kef[2];
#pragma unroll
              for (int e = 0; e < 2; ++e) { const int jj = 16 * tq + i + e; const float bb = bl[i + e] + prefix;
                  LAS unsigned short* qp = (LAS unsigned short*)(lds + G_Q + jj * 272 + 2 * d); LAS unsigned short* kp = (LAS unsigned short*)(lds + G_K + jj * 272 + 2 * d);
                  const float qv = bf2f(*qp), kv = bf2f(*kp);
                  *qp = f2bf(qv * __expf(bb)); *kp = f2bf(kv * __expf(-bb)); kef[e] = kv * __expf(blast - bb); }
              kew[i >> 1] = pk2(kef[0], kef[1]); }
          *(LAS u32x4*)(lds + G_KE + d * 144 + 32 * tq) = (u32x4){kew[0], kew[1], kew[2], kew[3]};
          *(LAS u32x4*)(lds + G_KE + d * 144 + 32 * tq + 16) = (u32x4){kew[4], kew[5], kew[6], kew[7]};
          if (tq == 0) ((LAS float*)(lds + G_EBL))[d] = __expf(blast); }
        __syncthreads();
        { const int ti = wave >> 1;
#pragma unroll
          for (int u = 0; u < 2; ++u) { const int si = 2 * (wave & 1) + u; f32x4 acc = (f32x4){0.f, 0.f, 0.f, 0.f};
#pragma unroll
              for (int ks = 0; ks < 4; ++ks) { const bf16x8 a = *(const LAS bf16x8*)(lds + G_K + (16 * si + l15) * 272 + (32 * ks + 8 * lg) * 2);
                  const bf16x8 bq = *(const LAS bf16x8*)(lds + G_Q + (16 * ti + l15) * 272 + (32 * ks + 8 * lg) * 2); acc = MFMA16(a, bq, acc); }
              const int t = 16 * ti + l15, s0 = 16 * si + 4 * lg; float pv[4];
#pragma unroll
              for (int r = 0; r < 4; ++r) { const int s = s0 + r; const bool keep = dir ? (s < t) : (s <= t); pv[r] = keep ? acc[r] : 0.f; }
              *(LAS u32x2*)(lds + G_P + t * 144 + s0 * 2) = (u32x2){pk2(pv[0], pv[1]), pk2(pv[2], pv[3])}; } }
        __syncthreads();
        bf16x8 av[2], as[4];
#pragma unroll
        for (int ks = 0; ks < 2; ++ks) av[ks] = *(const LAS bf16x8*)(lds + G_VT + (16 * wave + l15) * 144 + (32 * ks + 8 * lg) * 2);
#pragma unroll
        for (int ks = 0; ks < 4; ++ks) as[ks] = *(const LAS bf16x8*)(lds + G_ST + (16 * wave + l15) * 272 + (32 * ks + 8 * lg) * 2);
#pragma unroll
        for (int tt = 0; tt < 4; ++tt) { f32x4 acc = (f32x4){0.f, 0.f, 0.f, 0.f};
#pragma unroll
            for (int ks = 0; ks < 2; ++ks) { const bf16x8 bp = *(const LAS bf16x8*)(lds + G_P + (16 * tt + l15) * 144 + (32 * ks + 8 * lg) * 2); acc = MFMA16(av[ks], bp, acc); }
#pragma unroll
            for (int ks = 0; ks < 4; ++ks) { const bf16x8 bq = *(const LAS bf16x8*)(lds + G_Q + (16 * tt + l15) * 272 + (32 * ks + 8 * lg) * 2); acc = MFMA16(as[ks], bq, acc); }
            const size_t tok = GLA_TOK(n, 16 * tt + l15);
            *(u32x2*)(ob + tok * 1024 + h * 256 + vh * 128 + 16 * wave + 4 * lg) = (u32x2){pk2(acc[0], acc[1]), pk2(acc[2], acc[3])}; }
#pragma unroll
        for (int dt = 0; dt < 8; ++dt) { const f32x4 e4 = *(const LAS f32x4*)(lds + G_EBL + (16 * dt + 4 * lg) * 4); st[dt] = st[dt] * e4;
#pragma unroll
            for (int ks = 0; ks < 2; ++ks) { const bf16x8 a = *(const LAS bf16x8*)(lds + G_KE + (16 * dt + l15) * 144 + (32 * ks + 8 * lg) * 2); st[dt] = MFMA16(a, av[ks], st[dt]); }
            *(LAS u32x2*)(lds + G_ST + (16 * wave + l15) * 272 + (16 * dt + 4 * lg) * 2) = (u32x2){pk2(st[dt][0], st[dt][1]), pk2(st[dt][2], st[dt][3])}; }
        __syncthreads();
    }
#undef GLA_LOAD
#undef GLA_TOK
}

constexpr int M_VNT = 0, M_WS = 34816, M_MU = 69632, M_RS = 70144;
__device__ __forceinline__ void gmlp_item(LAS unsigned char* lds, const bf16* __restrict__ gv, bf16* ug, const float* __restrict__ lng, const float* __restrict__ lnb,
                                          const float* __restrict__ wsp, const float* __restrict__ bsp, int item, int tid) {
    const int lane = tid & 63, wave = __builtin_amdgcn_readfirstlane(tid >> 6), l15 = lane & 15, lg = lane >> 4;
    const size_t T0 = (size_t)(item >> 4) * S + (size_t)(item & 15) * 128;
    LAS float* MU = (LAS float*)(lds + M_MU); LAS float* RS = (LAS float*)(lds + M_RS);
    for (int rr = 0; rr < 16; ++rr) { const int row = 16 * wave + rr; const u32x4* p = (const u32x4*)(gv + (T0 + row) * 1024);
        const u32x4 x0 = p[lane], x1 = p[64 + lane]; float s = 0.f, s2 = 0.f;
#define ACC2(w) do { const float a_ = bf_lo(w), b_ = bf_hi(w); s += a_ + b_; s2 += a_ * a_ + b_ * b_; } while (0)
        ACC2(x0.x); ACC2(x0.y); ACC2(x0.z); ACC2(x0.w); ACC2(x1.x); ACC2(x1.y); ACC2(x1.z); ACC2(x1.w);
#undef ACC2
        s = wave_sum(s); s2 = wave_sum(s2);
        const float mu = s * (1.0f / 1024.0f), var = fmaxf(s2 * (1.0f / 1024.0f) - mu * mu, 0.f);
        if (lane == 0) { MU[row] = mu; RS[row] = 1.0f / sqrtf(var + EPS); } }
    __syncthreads();
    for (int g = 0; g < 8; ++g) {
        { const int s = tid & 127; const float mu = MU[s], rs = RS[s];
#pragma unroll
          for (int i = 0; i < 4; ++i) { const int c8 = (tid >> 7) + 4 * i; const u32x4 raw = *(const u32x4*)(gv + (T0 + s) * 1024 + 128 * g + 8 * c8);
              const f32x4 g0 = *(const f32x4*)(lng + 128 * g + 8 * c8), g1 = *(const f32x4*)(lng + 128 * g + 8 * c8 + 4), b0 = *(const f32x4*)(lnb + 128 * g + 8 * c8), b1 = *(const f32x4*)(lnb + 128 * g + 8 * c8 + 4);
              LAS unsigned short* vt = (LAS unsigned short*)(lds + M_VNT + (8 * c8) * 272 + 2 * s);
              vt[0 * 136] = f2bf((bf_lo(raw.x) - mu) * rs * g0[0] + b0[0]); vt[1 * 136] = f2bf((bf_hi(raw.x) - mu) * rs * g0[1] + b0[1]);
              vt[2 * 136] = f2bf((bf_lo(raw.y) - mu) * rs * g0[2] + b0[2]); vt[3 * 136] = f2bf((bf_hi(raw.y) - mu) * rs * g0[3] + b0[3]);
              vt[4 * 136] = f2bf((bf_lo(raw.z) - mu) * rs * g1[0] + b1[0]); vt[5 * 136] = f2bf((bf_hi(raw.z) - mu) * rs * g1[1] + b1[1]);
              vt[6 * 136] = f2bf((bf_lo(raw.w) - mu) * rs * g1[2] + b1[2]); vt[7 * 136] = f2bf((bf_hi(raw.w) - mu) * rs * g1[3] + b1[3]); } }
#pragma unroll
        for (int i = 0; i < 8; ++i) { const int p = tid + 512 * i, t = p >> 5, s4 = p & 31; const f32x4 w4 = *(const f32x4*)(wsp + ((size_t)g * 128 + t) * 128 + 4 * s4);
            *(LAS u32x2*)(lds + M_WS + t * 272 + 8 * s4) = (u32x2){pk2(w4[0], w4[1]), pk2(w4[2], w4[3])}; }
        __syncthreads();
        bf16x8 a[4];
#pragma unroll
        for (int ks = 0; ks < 4; ++ks) a[ks] = *(const LAS bf16x8*)(lds + M_VNT + (16 * wave + l15) * 272 + (32 * ks + 8 * lg) * 2);
#pragma unroll
        for (int tt = 0; tt < 8; ++tt) { f32x4 acc = (f32x4){0.f, 0.f, 0.f, 0.f};
#pragma unroll
            for (int ks = 0; ks < 4; ++ks) { const bf16x8 bw = *(const LAS bf16x8*)(lds + M_WS + (16 * tt + l15) * 272 + (32 * ks + 8 * lg) * 2); acc = MFMA16(a[ks], bw, acc); }
            const int t = 16 * tt + l15; const float bias = bsp[g * 128 + t];
            u32x2* up = (u32x2*)(ug + (T0 + t) * 1024 + 128 * g + 16 * wave + 4 * lg); const u32x2 uu = *up;
            *up = (u32x2){pk2((acc[0] + bias) * bf_lo(uu.x), (acc[1] + bias) * bf_hi(uu.x)), pk2((acc[2] + bias) * bf_lo(uu.y), (acc[3] + bias) * bf_hi(uu.y))}; }
        __syncthreads();
    }
}

#define GRID_SYNC() do { asm volatile("s_waitcnt vmcnt(0) lgkmcnt(0)" ::: "memory"); grid.sync(); __builtin_amdgcn_fence(__ATOMIC_ACQUIRE, "agent"); asm volatile("s_waitcnt vmcnt(0)" ::: "memory"); } while (0)
__global__ void __launch_bounds__(NTHR, 2) fwd_megakernel(Args args) {
    extern __shared__ __attribute__((aligned(16))) unsigned char lds_raw[];
    LAS unsigned char* lds = (LAS unsigned char*)lds_raw;
    cg::grid_group grid = cg::this_grid();
    const int tid = threadIdx.x, lane = tid & 63, wave = __builtin_amdgcn_readfirstlane(tid >> 6);
    const int G = gridDim.x, bx = blockIdx.x;
    const int gw = bx * NWAVES + wave, NGW = G * NWAVES;
    unsigned char* ws = args.ws;
    const float* x = args.in[0]; float* out = args.out;
    float* mod = (float*)(ws + WS_MOD);
    bf16* Win_t = (bf16*)(ws + WS_WIN); bf16* Wg_t = (bf16*)(ws + WS_WG); bf16* Wm_t = (bf16*)(ws + WS_WM); bf16* Wo_t = (bf16*)(ws + WS_WO);
    float* RA = (float*)(ws + WS_RA);
    bf16* Qb = (bf16*)(ws + WS_Q); bf16* Kb = (bf16*)(ws + WS_K); bf16* Vb = (bf16*)(ws + WS_V); bf16* SZ = (bf16*)(ws + WS_SZ); bf16* UG = (bf16*)(ws + WS_UG);
    bf16* GV = (bf16*)(ws + WS_GV); bf16* SMG = (bf16*)(ws + WS_SMG); bf16* SMM = (bf16*)(ws + WS_SMM); bf16* MG = (bf16*)(ws + WS_MG);
    bf16* XN = (bf16*)out; bf16* OFW = (bf16*)out; bf16* OBW = (bf16*)out + (size_t)M * 1024;

    if (bx < 48) p0_mod(lds, args.in[1], args.in[3], args.in[4], mod, bx, tid);
    {
        LAS float* scr = (LAS float*)(lds + wave * 16384);
        constexpr int I_IN = 16 * 264, I_SQ = 16 * 32, NITEMS = I_IN + 3 * I_SQ;
        for (int it = gw; it < NITEMS; it += NGW) {
            int r = it;
            if (r < I_IN) { const int kb = r / 264, db = r % 264, sb = win_src_block(db); transpose_item(args.in[5], NIN_SRC, Win_t, D, 32 * db, sb < 0 ? -1 : 32 * sb, 64 * kb, scr, lane); continue; } r -= I_IN;
            const int w = r / I_SQ; r -= w * I_SQ;
            const float* src = args.in[15 + w]; bf16* dst = w == 0 ? Wg_t : (w == 1 ? Wm_t : Wo_t);
            transpose_item(src, D, dst, D, 32 * (r % 32), 32 * (r % 32), 64 * (r / 32), scr, lane);
        }
    }
    GRID_SYNC();
    {
        const float* ng = args.in[2];
        for (int m = gw; m < M; m += NGW) {
            const f32x4* xr = (const f32x4*)(x + (size_t)m * D) + lane; const float* mb = mod + (size_t)(m >> 11) * 3072;
            f32x4 v[4]; float ss = 0.f;
#pragma unroll
            for (int j = 0; j < 4; ++j) { v[j] = xr[64 * j]; ss += (v[j][0] * v[j][0] + v[j][1] * v[j][1]) + (v[j][2] * v[j][2] + v[j][3] * v[j][3]); }
            const float r = 1.0f / sqrtf(wave_sum(ss) * (1.0f / D) + EPS);
#pragma unroll
            for (int j = 0; j < 4; ++j) { const int col = 256 * j + 4 * lane; const f32x4 g4 = *(const f32x4*)(ng + col), sc4 = *(const f32x4*)(mb + 1024 + col), sh4 = *(const f32x4*)(mb + col);
                const f32x4 hv = v[j] * r * g4 * (sc4 + 1.0f) + sh4;
                *(u32x2*)(XN + (size_t)m * D + col) = (u32x2){pk2(hv[0], hv[1]), pk2(hv[2], hv[3])}; }
        }
    }
    GRID_SYNC();
    {
        pg8::Gemm g{XN, Win_t, M, NINP, D}; pg8::StaticOrder So; So.init(M, NINP, G, bx);
        pg8::EpiIn E{Qb, Kb, Vb, SZ, UG, GV, SMG, SMM, RA};
        pg8::gemm_phase<pg8::EpiIn, pg8::StaticOrder, PG8_ALIGN, PG8_SP2>(lds, g, So, E);
    }
    GRID_SYNC();
    for (int it = bx; it < 256; it += G) {
        const int vh = it & 1, dir = (it >> 1) & 1, h = (it >> 2) & 3, b = it >> 4;
        gla_item(lds, Qb, Kb, Vb, RA, dir ? args.in[8] : args.in[6], dir ? args.in[9] : args.in[7], dir ? OBW : OFW, b, h, dir, vh, tid);
    }
    for (int it = bx; it < 256; it += G) gmlp_item(lds, GV, UG, args.in[11], args.in[12], args.in[13], args.in[14], it, tid);
    GRID_SYNC();
    {
        const float* gg = args.in[10];
        for (int m = gw; m < M; m += NGW) {
            const size_t off = (size_t)m * 1024 + 16 * lane;
            const u32x4 f0 = *(const u32x4*)(OFW + off), f1 = *(const u32x4*)(OFW + off + 8), b0 = *(const u32x4*)(OBW + off), b1 = *(const u32x4*)(OBW + off + 8);
            const u32x4 z0 = *(const u32x4*)(SZ + off), z1 = *(const u32x4*)(SZ + off + 8);
            float o[16];
#define SUM2(i, fw, bw) o[i] = bf_lo(fw) + bf_lo(bw); o[i + 1] = bf_hi(fw) + bf_hi(bw)
            SUM2(0, f0.x, b0.x); SUM2(2, f0.y, b0.y); SUM2(4, f0.z, b0.z); SUM2(6, f0.w, b0.w); SUM2(8, f1.x, b1.x); SUM2(10, f1.y, b1.y); SUM2(12, f1.z, b1.z); SUM2(14, f1.w, b1.w);
#undef SUM2
            float ss = 0.f;
#pragma unroll
            for (int i = 0; i < 16; ++i) ss += o[i] * o[i];
            ss += __shfl_xor(ss, 1); ss += __shfl_xor(ss, 2); ss += __shfl_xor(ss, 4); ss += __shfl_xor(ss, 8);
            const float r = 1.0f / sqrtf(ss * (1.0f / 256.0f) + EPS);
            const f32x4* gp = (const f32x4*)(gg + 16 * lane); const f32x4 g0 = gp[0], g1 = gp[1], g2 = gp[2], g3 = gp[3];
            const float gs[16] = {g0[0], g0[1], g0[2], g0[3], g1[0], g1[1], g1[2], g1[3], g2[0], g2[1], g2[2], g2[3], g3[0], g3[1], g3[2], g3[3]};
            const unsigned zw[8] = {z0.x, z0.y, z0.z, z0.w, z1.x, z1.y, z1.z, z1.w};
            unsigned ow[8];
#pragma unroll
            for (int i = 0; i < 8; ++i) ow[i] = pk2(o[2 * i] * r * gs[2 * i] * bf_lo(zw[i]), o[2 * i + 1] * r * gs[2 * i + 1] * bf_hi(zw[i]));
            *(u32x4*)(SZ + off) = (u32x4){ow[0], ow[1], ow[2], ow[3]}; *(u32x4*)(SZ + off + 8) = (u32x4){ow[4], ow[5], ow[6], ow[7]};
        }
    }
    GRID_SYNC();
    {
        pg8::StaticOrder So; So.init(M, D, G, bx);
        { pg8::Gemm g{SZ, Wg_t, M, D, D}; pg8::EpiMerge<true> E{SMG, MG}; pg8::gemm_phase<pg8::EpiMerge<true>, pg8::StaticOrder, PG8_ALIGN, PG8_SP2>(lds, g, So, E); }
        { pg8::Gemm g{UG, Wm_t, M, D, D}; pg8::EpiMerge<false> E{SMM, MG}; pg8::gemm_phase<pg8::EpiMerge<false>, pg8::StaticOrder, PG8_ALIGN, PG8_SP2>(lds, g, So, E); }
    }
    GRID_SYNC();
    {
        pg8::Gemm g{MG, Wo_t, M, D, D}; pg8::StaticOrder So; So.init(M, D, G, bx);
        pg8::EpiOut E{x, mod + 2048, out};
        pg8::gemm_phase<pg8::EpiOut, pg8::StaticOrder, PG8_ALIGN, PG8_SP2>(lds, g, So, E);
    }
    GRID_SYNC();
    {
        const float* fg = args.in[18];
        for (int m = gw; m < M; m += NGW) {
            f32x4* xr = (f32x4*)(out + (size_t)m * D) + lane;
            f32x4 v[4]; float ss = 0.f;
#pragma unroll
            for (int j = 0; j < 4; ++j) { v[j] = xr[64 * j]; ss += (v[j][0] * v[j][0] + v[j][1] * v[j][1]) + (v[j][2] * v[j][2] + v[j][3] * v[j][3]); }
            const float r = 1.0f / sqrtf(wave_sum(ss) * (1.0f / D) + EPS);
#pragma unroll
            for (int j = 0; j < 4; ++j) xr[64 * j] = v[j] * r * *(const f32x4*)(fg + 256 * j + 4 * lane);
        }
    }
}

extern "C" void kernel_launch(void* const* d_in, const int* in_sizes, int n_in, void* d_out, int out_size, void* d_ws, size_t ws_size, hipStream_t stream) {
    static int grid = 0;
    if (grid == 0) {
        if (n_in != 19 || in_sizes[0] != M * D || out_size != M * D || ws_size < WS_END) { fprintf(stderr, "kernel_launch: unexpected shapes (n_in %d, in0 %d, out %d, ws %zu); nothing launched\n", n_in, n_in > 0 ? in_sizes[0] : -1, out_size, ws_size); grid = -1; return; }
        int dev = 0, cus = 0, per_cu = 0;
        if (hipGetDevice(&dev) != hipSuccess || hipDeviceGetAttribute(&cus, hipDeviceAttributeMultiprocessorCount, dev) != hipSuccess) { grid = -1; return; }
        if (hipFuncSetAttribute((const void*)fwd_megakernel, hipFuncAttributeMaxDynamicSharedMemorySize, LDS_BYTES) != hipSuccess) { fprintf(stderr, "kernel_launch: hipFuncSetAttribute failed\n"); grid = -1; return; }
        if (hipOccupancyMaxActiveBlocksPerMultiprocessor(&per_cu, (const void*)fwd_megakernel, NTHR, LDS_BYTES) != hipSuccess || per_cu < 1) { fprintf(stderr, "kernel_launch: occupancy query says %d blocks per CU; nothing launched\n", per_cu); (void)hipGetLastError(); grid = -1; return; }
        grid = cus * (per_cu < 1 ? 1 : 1);
    }
    if (grid < 0) return;
    Args a{};
    for (int i = 0; i < 19; ++i) a.in[i] = (const float*)d_in[i];
    a.out = (float*)d_out; a.ws = (unsigned char*)d_ws;
    void* kargs[] = {&a};
    const hipError_t e = hipLaunchCooperativeKernel((const void*)fwd_megakernel, dim3(grid), dim3(NTHR), kargs, LDS_BYTES, stream);
    if (e != hipSuccess) fprintf(stderr, "kernel_launch: cooperative launch failed: %s (grid %d)\n", hipGetErrorString(e), grid);
}
```

```cpp
#include <hip/hip_runtime.h>
#include <hip/hip_cooperative_groups.h>
#include <cstdio>
#include <cstdint>
namespace cg = cooperative_groups;
namespace pg8 {
#define PG8_LAS __attribute__((address_space(3)))
typedef unsigned short bf16_t;
typedef short bf16x8 __attribute__((ext_vector_type(8)));
typedef float f32x4 __attribute__((ext_vector_type(4)));
typedef unsigned u32x4 __attribute__((ext_vector_type(4)));
constexpr int BM = 256, BK = 64, HALF = 128, HTB = HALF * BK * 2  , STAGE_BYTES = 8 * HTB, NXCD = 8, WGM = 8;

__host__ __device__ __forceinline__ int lds_byte(int r, int c) { const int st = (r >> 4) * 2 + (c >> 5), rr = r & 15, cc = c & 31, ob = rr * 64 + cc * 2; return st * 1024 + (ob ^ (((ob >> 9) & 1) << 5)); }
__host__ __device__ __forceinline__ void stage_rc(int b, int& R, int& C) { const int st = b / 1024, sb = b % 1024, swz = sb ^ (((sb >> 9) & 1) << 5); R = (st >> 1) * 16 + swz / 64; C = (st & 1) * 32 + (swz % 64) / 2; }
__host__ __device__ __forceinline__ int perm32(int rho) { const int n = rho >> 4, i = rho & 15; return 8 * (i >> 2) + 4 * n + (i & 3); }

struct Unit { int pm, pn; };
struct Gemm { const bf16_t* A; const bf16_t* Bt; int M, N, K; };

struct StaticOrder {
    int nM, nN, nwg, G, c;
    __host__ __device__ void init(int M, int N, int G_, int c_) { nM = M / BM; nN = N / BM; nwg = nM * nN; G = G_; c = c_; }
    __host__ __device__ bool next(int i, Unit& u) const {
        const long L = (long)i * G + c; if (L >= nwg) return false;
        int wgid = (int)L; { const int q = nwg / NXCD, r = nwg % NXCD, xcd = wgid % NXCD, off = wgid / NXCD; wgid = (xcd < r ? xcd * (q + 1) : r * (q + 1) + (xcd - r) * q) + off; }
        const int nig = WGM * nN, gid = wgid / nig, fm = gid * WGM, gsz = (nM - fm) < WGM ? (nM - fm) : WGM;
        u.pm = fm + ((wgid % nig) % gsz); u.pn = (wgid % nig) / gsz; return true;
    }
    __device__ __forceinline__ void a_ready(const Unit&) const {}
    __device__ __forceinline__ void done(const Unit&) const {}
};

typedef float f32x2c_t __attribute__((ext_vector_type(2)));
typedef __bf16 bf16x2c_t __attribute__((ext_vector_type(2)));
__device__ __forceinline__ unsigned cvt_pk_bf16(float lo, float hi) { const f32x2c_t v = {lo, hi}; const bf16x2c_t b = __builtin_convertvector(v, bf16x2c_t); return __builtin_bit_cast(unsigned, b); }
typedef float f32x2 __attribute__((ext_vector_type(2)));
__device__ __forceinline__ f32x2 gelu_pk(f32x2 v) {
    const f32x2 av = __builtin_elementwise_abs(v), d = av * 0.2316418882f + 1.0f;
    f32x2 t; t.x = __builtin_amdgcn_rcpf(d.x); t.y = __builtin_amdgcn_rcpf(d.y);
    f32x2 q = t * 0.5307027145f + (-0.7265760135f); q = q * t + 0.7107068705f; q = q * t + (-0.142248368f); q = q * t + 0.127414796f; q = q * t;
    const f32x2 s = (v * v) * (-0.72134752044f);
    f32x2 e; e.x = __builtin_amdgcn_exp2f(s.x); e.y = __builtin_amdgcn_exp2f(s.y);
    const f32x2 m = v * (q * e), r = v - m;
    f32x2 o; o.x = v.x < 0.f ? m.x : r.x; o.y = v.y < 0.f ? m.y : r.y; return o;
}

template <class Epi, class Sched, bool ALIGN_EPI = false, bool SP2 = false>
__device__ __forceinline__ void gemm_phase(PG8_LAS unsigned char* lds, const Gemm g, const Sched& S, const Epi& E) {
    const int tid = threadIdx.x, wid = __builtin_amdgcn_readfirstlane(tid >> 6), lane = tid & 63, wr = wid >> 2, wc = wid & 3, fr = lane & 15, fq = lane >> 4;
    const int K = g.K, nt = K / BK;
    unsigned voffA[2], voffB[2];
#pragma unroll
    for (int i = 0; i < 2; ++i) { int R, C; stage_rc(tid * 16 + i * 8192, R, C); const int Rb = Epi::PERM ? ((R & ~31) + perm32(R & 31)) : R;
        voffA[i] = (unsigned)(R * K + C) * 2u; voffB[i] = (unsigned)(Rb * K + C) * 2u; }
    const size_t kstep = (size_t)(BK * 2);
    const size_t hstep = (size_t)HALF * K * 2;
    const size_t tstep = 2 * hstep;
    const unsigned ldsw = (unsigned)wid * 1024u;
    const int aoff = lds_byte(wr * 64 + fr, fq * 8), boff = lds_byte(wc * 32 + fr, fq * 8);
#define PG8_SA(b, h) (((b) * 2 + (h)) * HTB)
#define PG8_SB(b, h) ((4 + (b) * 2 + (h)) * HTB)
#define PG8_STAGE(bufoff, gbase, voff) do { _Pragma("unroll") for (int _i = 0; _i < 2; ++_i) \
        __builtin_amdgcn_global_load_lds((const unsigned*)((const char*)(gbase) + (voff)[_i]), (PG8_LAS unsigned*)(lds + (bufoff) + ldsw + _i * 8192), 16, 0, 0); } while (0)
#define PG8_LDA(dst, b, h) do { _Pragma("unroll") for (int m = 0; m < 4; ++m) _Pragma("unroll") for (int k = 0; k < 2; ++k) dst[m][k] = *(const PG8_LAS bf16x8*)(lds + PG8_SA(b, h) + aoff + m * 2048 + k * 1024); } while (0)
#define PG8_LDB(dst, b, h) do { _Pragma("unroll") for (int n = 0; n < 2; ++n) _Pragma("unroll") for (int k = 0; k < 2; ++k) dst[n][k] = *(const PG8_LAS bf16x8*)(lds + PG8_SB(b, h) + boff + n * 2048 + k * 1024); } while (0)
#define PG8_MMA(ai, bj, At, Bt) do { __builtin_amdgcn_s_setprio(1); _Pragma("unroll") for (int m = 0; m < 4; ++m) _Pragma("unroll") for (int n = 0; n < 2; ++n) _Pragma("unroll") for (int k = 0; k < 2; ++k) \
        acc[ai][bj][m][n] = __builtin_amdgcn_mfma_f32_16x16x32_bf16(Bt[n][k], At[m][k], acc[ai][bj][m][n], 0, 0, 0); __builtin_amdgcn_s_setprio(0); } while (0)
#define PG8_WAIT_V(n) asm volatile("s_waitcnt vmcnt(" #n ")" ::: "memory")
#define PG8_WAIT_L(n) asm volatile("s_waitcnt lgkmcnt(" #n ")" ::: "memory")
#define PG8_BAR __builtin_amdgcn_s_barrier()
#define PG8_SCHED __builtin_amdgcn_sched_barrier(0)
    Unit cur, nxt; int ui = 0;
    if (!S.next(0, cur)) return;
    f32x4 acc[2][2][4][2];
#pragma unroll
    for (int a = 0; a < 2; ++a)
#pragma unroll
        for (int b = 0; b < 2; ++b)
#pragma unroll
            for (int m = 0; m < 4; ++m)
#pragma unroll
                for (int n = 0; n < 2; ++n) acc[a][b][m][n] = (f32x4){0.f, 0.f, 0.f, 0.f};
    bf16x8 At[4][2], B0[2][2], B1[2][2];
    const char* cA = (const char*)g.A + (size_t)cur.pm * tstep; const char* cB = (const char*)g.Bt + (size_t)cur.pn * tstep;
    S.a_ready(cur);
    if constexpr (SP2) {
        PG8_STAGE(PG8_SB(0, 0), cB, voffB); PG8_STAGE(PG8_SB(0, 1), cB + hstep, voffB); PG8_STAGE(PG8_SA(0, 0), cA, voffA); PG8_STAGE(PG8_SA(0, 1), cA + hstep, voffA);
        if (wr == 1) PG8_BAR;
        PG8_WAIT_V(2); PG8_BAR;
        PG8_STAGE(PG8_SB(1, 0), cB + kstep, voffB); PG8_STAGE(PG8_SA(1, 0), cA + kstep, voffA); PG8_STAGE(PG8_SB(1, 1), cB + hstep + kstep, voffB);
        PG8_WAIT_V(6); PG8_BAR;
    } else {
        PG8_STAGE(PG8_SB(0, 0), cB, voffB); PG8_STAGE(PG8_SA(0, 0), cA, voffA); PG8_STAGE(PG8_SB(0, 1), cB + hstep, voffB); PG8_STAGE(PG8_SA(0, 1), cA + hstep, voffA);
        if (wr == 1) PG8_BAR;
        PG8_WAIT_V(4); PG8_BAR;
        PG8_STAGE(PG8_SB(1, 0), cB + kstep, voffB); PG8_STAGE(PG8_SA(1, 0), cA + kstep, voffA); PG8_STAGE(PG8_SB(1, 1), cB + hstep + kstep, voffB);
        PG8_WAIT_V(6); PG8_BAR;
    }
    for (;;) {
        const bool has_next = S.next(ui + 1, nxt);
        const char* nA = has_next ? (const char*)g.A + (size_t)nxt.pm * tstep : cA; const char* nB = has_next ? (const char*)g.Bt + (size_t)nxt.pn * tstep : cB;
        for (int t = 0; t < nt; t += 2) {
            const bool last = (t == nt - 2);
            const char* a1 = cA + (size_t)(t + 1) * kstep;
            const char* a2 = last ? nA : cA + (size_t)(t + 2) * kstep; const char* b2 = last ? nB : cB + (size_t)(t + 2) * kstep;
            const char* a3 = a2 + kstep; const char* b3 = b2 + kstep;
            if (last && has_next) S.a_ready(nxt);
            if constexpr (SP2) {
            PG8_LDB(B0, 0, 0); PG8_LDB(B1, 0, 1); PG8_SCHED; PG8_LDA(At, 0, 0); PG8_STAGE(PG8_SA(1, 1), a1 + hstep, voffA);
            PG8_WAIT_V(8); PG8_WAIT_L(0); PG8_BAR; PG8_MMA(0, 0, At, B0); PG8_MMA(0, 1, At, B1); PG8_BAR; PG8_SCHED;
            PG8_LDA(At, 0, 1); PG8_STAGE(PG8_SB(0, 0), b2, voffB); PG8_STAGE(PG8_SB(0, 1), b2 + hstep, voffB); PG8_STAGE(PG8_SA(0, 0), a2, voffA);
            PG8_WAIT_V(8); PG8_WAIT_L(0); PG8_BAR; PG8_MMA(1, 0, At, B0); PG8_MMA(1, 1, At, B1); PG8_BAR; PG8_SCHED;
            PG8_LDB(B0, 1, 0); PG8_LDB(B1, 1, 1); PG8_SCHED; PG8_LDA(At, 1, 0); PG8_STAGE(PG8_SA(0, 1), a2 + hstep, voffA);
            PG8_WAIT_V(8); PG8_WAIT_L(0); PG8_BAR; PG8_MMA(0, 0, At, B0); PG8_MMA(0, 1, At, B1); PG8_BAR; PG8_SCHED;
            PG8_LDA(At, 1, 1); PG8_STAGE(PG8_SB(1, 0), b3, voffB); PG8_STAGE(PG8_SB(1, 1), b3 + hstep, voffB); PG8_STAGE(PG8_SA(1, 0), a3, voffA);
            PG8_WAIT_V(8); PG8_WAIT_L(0); PG8_BAR; PG8_MMA(1, 0, At, B0); PG8_MMA(1, 1, At, B1); PG8_BAR; PG8_SCHED;
            } else {
            PG8_LDB(B0, 0, 0); PG8_SCHED; PG8_LDA(At, 0, 0); PG8_STAGE(PG8_SA(1, 1), a1 + hstep, voffA);
            PG8_WAIT_L(8); PG8_BAR; PG8_WAIT_L(0); PG8_MMA(0, 0, At, B0); PG8_BAR; PG8_SCHED;
            PG8_LDB(B1, 0, 1); PG8_STAGE(PG8_SB(0, 0), b2, voffB);
            PG8_BAR; PG8_WAIT_L(0); PG8_MMA(0, 1, At, B1); PG8_BAR;
            PG8_LDA(At, 0, 1); PG8_STAGE(PG8_SA(0, 0), a2, voffA);
            PG8_BAR; PG8_WAIT_L(0); PG8_MMA(1, 0, At, B0); PG8_BAR; PG8_SCHED;
            PG8_STAGE(PG8_SB(0, 1), b2 + hstep, voffB);
            PG8_WAIT_V(6); PG8_BAR; PG8_MMA(1, 1, At, B1); PG8_BAR;
            PG8_LDB(B0, 1, 0); PG8_SCHED; PG8_LDA(At, 1, 0); PG8_STAGE(PG8_SA(0, 1), a2 + hstep, voffA);
            PG8_WAIT_L(8); PG8_BAR; PG8_WAIT_L(0); PG8_MMA(0, 0, At, B0); PG8_BAR; PG8_SCHED;
            PG8_LDB(B1, 1, 1); PG8_STAGE(PG8_SB(1, 0), b3, voffB);
            PG8_BAR; PG8_WAIT_L(0); PG8_MMA(0, 1, At, B1); PG8_BAR;
            PG8_LDA(At, 1, 1); PG8_STAGE(PG8_SA(1, 0), a3, voffA);
            PG8_BAR; PG8_WAIT_L(0); PG8_MMA(1, 0, At, B0); PG8_BAR; PG8_SCHED;
            PG8_STAGE(PG8_SB(1, 1), b3 + hstep, voffB);
            PG8_WAIT_V(6); PG8_BAR; PG8_MMA(1, 1, At, B1); PG8_BAR;
            }
        }
        if constexpr (ALIGN_EPI) { if (wr == 0) PG8_BAR; }
        if constexpr (!Epi::AFTER_DRAIN) { E(acc, cur, wr, wc, fr, fq); S.done(cur); }
        if (!has_next) break;
#pragma unroll
        for (int a = 0; a < 2; ++a)
#pragma unroll
            for (int b = 0; b < 2; ++b)
#pragma unroll
                for (int m = 0; m < 4; ++m)
#pragma unroll
                    for (int n = 0; n < 2; ++n) acc[a][b][m][n] = (f32x4){0.f, 0.f, 0.f, 0.f};
        cur = nxt; cA = nA; cB = nB; ++ui;
        if constexpr (ALIGN_EPI) { if (wr == 1) PG8_BAR; }
    }
    PG8_WAIT_V(0);
    if constexpr (!ALIGN_EPI) { if (wr == 0) PG8_BAR; }
    PG8_BAR;
    if constexpr (Epi::AFTER_DRAIN) { E.fused(acc, cur, wr, wc, fr, fq, lds, wid, lane); S.done(cur); }
#undef PG8_SA
#undef PG8_SB
#undef PG8_STAGE
#undef PG8_LDA
#undef PG8_LDB
#undef PG8_MMA
#undef PG8_WAIT_V
#undef PG8_WAIT_L
#undef PG8_BAR
#undef PG8_SCHED
}
__device__ __forceinline__ float fsigmoid(float x) { return __builtin_amdgcn_rcpf(1.0f + __expf(-x)); }
__device__ __forceinline__ float fsilu(float x) { return x * fsigmoid(x); }
__device__ __forceinline__ f32x4 gelu4(f32x4 v) { const f32x2 a = gelu_pk((f32x2){v[0], v[1]}), b = gelu_pk((f32x2){v[2], v[3]}); return (f32x4){a.x, a.y, b.x, b.y}; }
__device__ __forceinline__ f32x4 silu4(f32x4 v) { return (f32x4){fsilu(v[0]), fsilu(v[1]), fsilu(v[2]), fsilu(v[3])}; }
__device__ __forceinline__ f32x4 sigm4(f32x4 v) { return (f32x4){fsigmoid(v[0]), fsigmoid(v[1]), fsigmoid(v[2]), fsigmoid(v[3])}; }
__device__ __forceinline__ f32x4 act4(int act, f32x4 v, float sc) {
    if (act == 0) return v * sc;
    if (act == 1) return silu4(v);
    if (act == 2) return gelu4(v);
    return sigm4(v);
}
__device__ __forceinline__ u32x4 pack8(f32x4 v0, f32x4 v1) { u32x4 w; w.x = cvt_pk_bf16(v0[0], v0[1]); w.y = cvt_pk_bf16(v0[2], v0[3]); w.z = cvt_pk_bf16(v1[0], v1[1]); w.w = cvt_pk_bf16(v1[2], v1[3]); return w; }
__device__ __forceinline__ float bf_lo(unsigned w) { return __uint_as_float(w << 16); }
__device__ __forceinline__ float bf_hi(unsigned w) { return __uint_as_float(w & 0xffff0000u); }

struct EpiIn {
    static constexpr bool PERM = true, AFTER_DRAIN = false;
    bf16_t *q, *k, *v, *sz, *ug, *gv, *smg, *smm; float* ra;
    __device__ __forceinline__ void operator()(const f32x4 (&acc)[2][2][4][2], const Unit& u, int wr, int wc, int fr, int fq) const {
        const int pn = u.pn, row0 = u.pm * BM + wr * 64 + fr, cw = wc * 32 + 8 * fq;
        if (pn == 32) {
            if (wc == 0) {
#pragma unroll
                for (int ai = 0; ai < 2; ++ai)
#pragma unroll
                    for (int m = 0; m < 4; ++m) { float* rp = ra + (size_t)(row0 + ai * HALF + m * 16) * 32 + 8 * fq; *(f32x4*)rp = acc[ai][0][m][0]; *(f32x4*)(rp + 4) = acc[ai][0][m][1]; }
            }
            return;
        }
        if (pn >= 12 && pn < 20) {
            const int T = pn - 12;
#pragma unroll
            for (int ai = 0; ai < 2; ++ai)
#pragma unroll
                for (int m = 0; m < 4; ++m) { bf16_t* rp = ug + (size_t)(row0 + ai * HALF + m * 16) * 1024 + 128 * T + cw;
                    const f32x4 a0 = gelu4(acc[ai][0][m][0]) * silu4(acc[ai][1][m][0]), a1 = gelu4(acc[ai][0][m][1]) * silu4(acc[ai][1][m][1]);
                    *(u32x4*)rp = pack8(a0, a1); }
            return;
        }
        bf16_t* base; int ld = 1024, colt, act; float sc = 1.f;
        if (pn < 2) { base = q; ld = 512; colt = pn * 256; act = 0; sc = 0.08838834764831845f; }
        else if (pn < 4) { base = k; ld = 512; colt = (pn - 2) * 256; act = 0; }
        else if (pn < 8) { base = v; colt = (pn - 4) * 256; act = 0; }
        else if (pn < 12) { base = sz; colt = (pn - 8) * 256; act = 1; }
        else if (pn < 24) { base = gv; colt = (pn - 20) * 256; act = 2; }
        else if (pn < 28) { base = smg; colt = (pn - 24) * 256; act = 3; }
        else { base = smm; colt = (pn - 28) * 256; act = 3; }
#pragma unroll
        for (int ai = 0; ai < 2; ++ai)
#pragma unroll
            for (int m = 0; m < 4; ++m) { bf16_t* rp = base + (size_t)(row0 + ai * HALF + m * 16) * ld + colt + cw;
#pragma unroll
                for (int bj = 0; bj < 2; ++bj) *(u32x4*)(rp + bj * HALF) = pack8(act4(act, acc[ai][bj][m][0], sc), act4(act, acc[ai][bj][m][1], sc)); }
    }
};
template <bool FIRST> struct EpiMerge {
    static constexpr bool PERM = true, AFTER_DRAIN = false;
    const bf16_t* gate; bf16_t* mg;
    __device__ __forceinline__ void operator()(const f32x4 (&acc)[2][2][4][2], const Unit& u, int wr, int wc, int fr, int fq) const {
        const int row0 = u.pm * BM + wr * 64 + fr, c0 = u.pn * BM + wc * 32 + 8 * fq;
#pragma unroll
        for (int ai = 0; ai < 2; ++ai)
#pragma unroll
            for (int m = 0; m < 4; ++m)
#pragma unroll
                for (int bj = 0; bj < 2; ++bj) { const size_t off = (size_t)(row0 + ai * HALF + m * 16) * 1024 + c0 + bj * HALF;
                    const u32x4 g = *(const u32x4*)(gate + off);
                    f32x4 v0 = acc[ai][bj][m][0] * (f32x4){bf_lo(g.x), bf_hi(g.x), bf_lo(g.y), bf_hi(g.y)}, v1 = acc[ai][bj][m][1] * (f32x4){bf_lo(g.z), bf_hi(g.z), bf_lo(g.w), bf_hi(g.w)};
                    if (!FIRST) { const u32x4 p = *(const u32x4*)(mg + off); v0 += (f32x4){bf_lo(p.x), bf_hi(p.x), bf_lo(p.y), bf_hi(p.y)}; v1 += (f32x4){bf_lo(p.z), bf_hi(p.z), bf_lo(p.w), bf_hi(p.w)}; }
                    *(u32x4*)(mg + off) = pack8(v0, v1); }
    }
};
struct EpiOut {
    static constexpr bool PERM = false, AFTER_DRAIN = false;
    const float* x; const float* gate; float* out;
    __device__ __forceinline__ void operator()(const f32x4 (&acc)[2][2][4][2], const Unit& u, int wr, int wc, int fr, int fq) const {
        const int row0 = u.pm * BM + wr * 64 + fr, c0 = u.pn * BM + wc * 32 + 4 * fq;
#pragma unroll
        for (int ai = 0; ai < 2; ++ai)
#pragma unroll
            for (int m = 0; m < 4; ++m) { const int row = row0 + ai * HALF + m * 16; const float* gp = gate + (size_t)(row >> 11) * 3072;
#pragma unroll
                for (int bj = 0; bj < 2; ++bj)
#pragma unroll
                    for (int n = 0; n < 2; ++n) { const int c = c0 + bj * HALF + 16 * n; const size_t off = (size_t)row * 1024 + c;
                        *(f32x4*)(out + off) = *(const f32x4*)(x + off) + *(const f32x4*)(gp + c) * acc[ai][bj][m][n]; } }
    }
};
}

#ifndef REP_P2
#define REP_P2 1
#endif
#ifndef REP_GLA
#define REP_GLA 1
#endif
#ifndef REP_P45
#define REP_P45 1
#endif
#ifndef PG8_SP2
#define PG8_SP2 true
#endif
#ifndef PG8_ALIGN
#define PG8_ALIGN true
#endif
#define LAS __attribute__((address_space(3)))
typedef unsigned short bf16;
typedef float f32x4 __attribute__((ext_vector_type(4)));
typedef short bf16x8 __attribute__((ext_vector_type(8)));
typedef unsigned u32x4 __attribute__((ext_vector_type(4)));
typedef unsigned u32x2 __attribute__((ext_vector_type(2)));
constexpr int NWAVES = 8, NTHR = 512;
constexpr int D = 1024, NB = 16, S = 2048, M = NB * S, NINP = 8448  , NIN_SRC = 8224;
constexpr float EPS = 1e-6f;
constexpr size_t MiB = 1u << 20;
constexpr size_t WS_MOD = 1 * MiB;
constexpr size_t WS_WIN = 2 * MiB, WS_WG = 19 * MiB, WS_WM = 21 * MiB, WS_WO = 23 * MiB;
constexpr size_t WS_RA = 26 * MiB;
constexpr size_t WS_Q = 32 * MiB, WS_K = 64 * MiB, WS_V = 96 * MiB, WS_SZ = 160 * MiB, WS_UG = 224 * MiB, WS_GV = 288 * MiB, WS_SMG = 352 * MiB, WS_SMM = 416 * MiB, WS_END = 480 * MiB;
constexpr size_t WS_MG = WS_Q;
constexpr int LDS_BYTES = 147456;

__device__ __forceinline__ unsigned pk2(float lo, float hi) { return pg8::cvt_pk_bf16(lo, hi); }
__device__ __forceinline__ float bf_lo(unsigned w) { return __uint_as_float(w << 16); }
__device__ __forceinline__ float bf_hi(unsigned w) { return __uint_as_float(w & 0xffff0000u); }
__device__ __forceinline__ float bf2f(unsigned short h) { return __uint_as_float((unsigned)h << 16); }
__device__ __forceinline__ unsigned short f2bf(float f) { return (unsigned short)(pk2(f, 0.f) & 0xffffu); }
__device__ __forceinline__ float wave_sum(float v) {
#pragma unroll
    for (int o = 1; o < 64; o <<= 1) v += __shfl_xor(v, o);
    return v;
}
#define MFMA16(a, b, c) __builtin_amdgcn_mfma_f32_16x16x32_bf16((a), (b), (c), 0, 0, 0)

__device__ __forceinline__ void p0_mod(LAS unsigned char* lds, const float* c, const float* w_ada, const float* b_ada, float* mod, int blk, int tid) {
    LAS float* sc = (LAS float*)lds;
    LAS float* red = (LAS float*)(lds + 65536);
    for (int i = tid; i < NB * D; i += NTHR) { const float v = c[i]; sc[(i & (D - 1)) * 16 + (i >> 10)] = v / (1.0f + __expf(-v)); }
    __syncthreads();
    const int wave = tid >> 6, lane = tid & 63, col = 64 * blk + lane;
    float acc[16];
#pragma unroll
    for (int b = 0; b < 16; ++b) acc[b] = 0.f;
    for (int k0 = 0; k0 < 128; k0 += 32) {
        float w[32];
#pragma unroll
        for (int j = 0; j < 32; ++j) w[j] = w_ada[(size_t)(wave * 128 + k0 + j) * 3072 + col];
#pragma unroll
        for (int j = 0; j < 32; ++j) { const LAS f32x4* sp = (const LAS f32x4*)(sc + (wave * 128 + k0 + j) * 16);
#pragma unroll
            for (int q = 0; q < 4; ++q) { const f32x4 s4 = sp[q]; acc[4 * q] += s4[0] * w[j]; acc[4 * q + 1] += s4[1] * w[j]; acc[4 * q + 2] += s4[2] * w[j]; acc[4 * q + 3] += s4[3] * w[j]; } }
    }
#pragma unroll
    for (int b = 0; b < 16; ++b) red[(wave * 16 + b) * 64 + lane] = acc[b];
    __syncthreads();
    for (int o = tid; o < 1024; o += NTHR) { const int b = o >> 6, l = o & 63; float s = b_ada[64 * blk + l];
#pragma unroll
        for (int w = 0; w < 8; ++w) s += red[(w * 16 + b) * 64 + l];
        mod[(size_t)b * 3072 + 64 * blk + l] = s; }
    __syncthreads();
}
__device__ __forceinline__ void transpose_item(const float* W, int Nsrc, bf16* WT, int K, int dst_row0, int src_col0, int k0, LAS float* scr, int lane) {
    if (src_col0 >= 0) {
        float t[32];
#pragma unroll
        for (int i = 0; i < 32; ++i) { const int kk = 2 * i + (lane >> 5); t[i] = W[(size_t)(k0 + kk) * Nsrc + src_col0 + (lane & 31)]; }
#pragma unroll
        for (int i = 0; i < 32; ++i) { const int kk = 2 * i + (lane >> 5); scr[kk * 33 + (lane & 31)] = t[i]; }
    } else {
#pragma unroll 8
        for (int i = 0; i < 32; ++i) { const int kk = 2 * i + (lane >> 5); scr[kk * 33 + (lane & 31)] = 0.f; }
    }
    asm volatile("s_waitcnt vmcnt(0) lgkmcnt(0)" ::: "memory");
    const int c = lane & 7;
#pragma unroll
    for (int j = 0; j < 4; ++j) { const int n = (lane >> 3) + 8 * j; const LAS float* s = scr + (8 * c) * 33 + n;
        u32x4 o; o.x = pk2(s[0 * 33], s[1 * 33]); o.y = pk2(s[2 * 33], s[3 * 33]); o.z = pk2(s[4 * 33], s[5 * 33]); o.w = pk2(s[6 * 33], s[7 * 33]);
        *(u32x4*)(WT + (size_t)(dst_row0 + n) * K + k0 + 8 * c) = o; }
    asm volatile("s_waitcnt lgkmcnt(0)" ::: "memory");
}
__device__ __forceinline__ int win_src_block(int db) {
    if (db < 96) return db;
    if (db < 160) { const int T = (db - 96) >> 3, r = (db - 96) & 7; return r < 4 ? 97 + 4 * T + r : 161 + 4 * T + (r - 4); }
    if (db < 192) return 129 + (db - 160);
    if (db < 224) return 193 + (db - 192);
    if (db < 256) return 225 + (db - 224);
    if (db == 256) return 96;
    return -1;
}

struct Args {
    const float* in[19]; float* out; unsigned char* ws;
};

constexpr int G_Q = 0, G_K = 17408, G_KE = 34816, G_VT = 53248, G_P = 71680, G_ST = 80896, G_RA = 115712, G_EBL = 119808, G_CS = 120320, G_END = 122368;
static_assert(G_END <= LDS_BYTES, "GLA LDS map");
__device__ __forceinline__ void gla_item(LAS unsigned char* lds, const bf16* __restrict__ qb, const bf16* __restrict__ kb, const bf16* __restrict__ vb, const float* __restrict__ rab,
                                         const float* __restrict__ aw_p, const float* __restrict__ ab_p, bf16* __restrict__ ob, int b, int h, int dir, int vh, int tid) {
    const int lane = tid & 63, wave = __builtin_amdgcn_readfirstlane(tid >> 6), l15 = lane & 15, lg = lane >> 4;
    const int d = tid & 127, tq = tid >> 7;
    float aw[16];
#pragma unroll
    for (int r = 0; r < 16; ++r) aw[r] = aw_p[r * 512 + h * 128 + d];
    const float ab = ab_p[h * 128 + d];
    f32x4 st[8];
#pragma unroll
    for (int i = 0; i < 8; ++i) st[i] = (f32x4){0.f, 0.f, 0.f, 0.f};
    for (int i = tid; i < 34816 / 16; i += NTHR) *(LAS u32x4*)(lds + G_ST + i * 16) = (u32x4){0u, 0u, 0u, 0u};
    u32x4 rq[2], rk[2], rv[2]; f32x4 rr = (f32x4){0.f, 0.f, 0.f, 0.f};
    const size_t tokb = (size_t)b * S;
#define GLA_TOK(n, r) (tokb + (size_t)(dir ? (S - 1 - (64 * (n) + (r))) : (64 * (n) + (r))))
#define GLA_LOAD(n) do { \
        _Pragma("unroll") for (int i = 0; i < 2; ++i) { const int p = tid + 512 * i, row = p >> 4, c8 = p & 15; const size_t tok = GLA_TOK(n, row); \
            rq[i] = *(const u32x4*)(qb + tok * 512 + h * 128 + c8 * 8); rk[i] = *(const u32x4*)(kb + tok * 512 + h * 128 + c8 * 8); } \
        _Pragma("unroll") for (int i = 0; i < 2; ++i) { const int s = tid & 63, c8 = (tid >> 6) + 8 * i; const size_t tok = GLA_TOK(n, s); \
            rv[i] = *(const u32x4*)(vb + tok * 1024 + h * 256 + vh * 128 + c8 * 8); } \
        if (tid < 256) { const int row = tid >> 2, part = tid & 3; rr = *(const f32x4*)(rab + GLA_TOK(n, row) * 32 + dir * 16 + part * 4); } } while (0)
    GLA_LOAD(0);
    for (int n = 0; n < 32; ++n) {
#pragma unroll
        for (int i = 0; i < 2; ++i) { const int p = tid + 512 * i, row = p >> 4, c8 = p & 15;
            *(LAS u32x4*)(lds + G_Q + row * 272 + c8 * 16) = rq[i]; *(LAS u32x4*)(lds + G_K + row * 272 + c8 * 16) = rk[i]; }
#pragma unroll
        for (int i = 0; i < 2; ++i) { const int s = tid & 63, c8 = (tid >> 6) + 8 * i; LAS unsigned short* vt = (LAS unsigned short*)(lds + G_VT + (c8 * 8) * 144 + 2 * s);
            vt[0 * 72] = (unsigned short)(rv[i].x & 0xffffu); vt[1 * 72] = (unsigned short)(rv[i].x >> 16); vt[2 * 72] = (unsigned short)(rv[i].y & 0xffffu); vt[3 * 72] = (unsigned short)(rv[i].y >> 16);
            vt[4 * 72] = (unsigned short)(rv[i].z & 0xffffu); vt[5 * 72] = (unsigned short)(rv[i].z >> 16); vt[6 * 72] = (unsigned short)(rv[i].w & 0xffffu); vt[7 * 72] = (unsigned short)(rv[i].w >> 16); }
        if (tid < 256) { const int row = tid >> 2, part = tid & 3; *(LAS f32x4*)(lds + G_RA + (row * 16 + part * 4) * 4) = rr; }
        if (n + 1 < 32) GLA_LOAD(n + 1);
        __syncthreads();
        float bl[16]; float run = 0.f;
#pragma unroll
        for (int i = 0; i < 16; ++i) { const int jj = 16 * tq + i; const LAS f32x4* rp = (const LAS f32x4*)(lds + G_RA + jj * 64);
            const f32x4 r0 = rp[0], r1 = rp[1], r2 = rp[2], r3 = rp[3];
            float z = ab;
            z += r0[0] * aw[0]; z += r0[1] * aw[1]; z += r0[2] * aw[2]; z += r0[3] * aw[3]; z += r1[0] * aw[4]; z += r1[1] * aw[5]; z += r1[2] * aw[6]; z += r1[3] * aw[7];
            z += r2[0] * aw[8]; z += r2[1] * aw[9]; z += r2[2] * aw[10]; z += r2[3] * aw[11]; z += r3[0] * aw[12]; z += r3[1] * aw[13]; z += r3[2] * aw[14]; z += r3[3] * aw[15];
            const float ls = fminf(z, 0.f) - __logf(1.0f + __expf(-fabsf(z)));
            run += fmaxf(ls * 0.0625f, -1.25f); bl[i] = run; }
        ((LAS float*)(lds + G_CS))[tq * 128 + d] = run;
        __syncthreads();
        { const LAS float* cs = (const LAS float*)(lds + G_CS); const float c0 = cs[d], c1 = cs[128 + d], c2 = cs[256 + d], c3 = cs[384 + d];
          const float prefix = (tq > 0 ? c0 : 0.f) + (tq > 1 ? c1 : 0.f) + (tq > 2 ? c2 : 0.f), blast = (c0 + c1) + (c2 + c3);
          unsigned kew[8];
#pragma unroll
          for (int i = 0; i < 16; i += 2) {
              float kef[2];
#pragma unroll
              for (int e = 0; e < 2; ++e) { const int jj = 16 * tq + i + e; const float bb = bl[i + e] + prefix;
                  LAS unsigned short* qp = (LAS unsigned short*)(lds + G_Q + jj * 272 + 2 * d); LAS unsigned short* kp = (LAS unsigned short*)(lds + G_K + jj * 272 + 2 * d);
                  const float qv = bf2f(*qp), kv = bf2f(*kp);
                  *qp = f2bf(qv * __expf(bb)); *kp = f2bf(kv * __expf(-bb)); kef[e] = kv * __expf(blast - bb); }
              kew[i >> 1] = pk2(kef[0], kef[1]); }
          *(LAS u32x4*)(lds + G_KE + d * 144 + 32 * tq) = (u32x4){kew[0], kew[1], kew[2], kew[3]};
          *(LAS u32x4*)(lds + G_KE + d * 144 + 32 * tq + 16) = (u32x4){kew[4], kew[5], kew[6], kew[7]};
          if (tq == 0) ((LAS float*)(lds + G_EBL))[d] = __expf(blast); }
        __syncthreads();
        { const int ti = wave >> 1;
#pragma unroll
          for (int u = 0; u < 2; ++u) { const int si = 2 * (wave & 1) + u; f32x4 acc = (f32x4){0.f, 0.f, 0.f, 0.f};
#pragma unroll
              for (int ks = 0; ks < 4; ++ks) { const bf16x8 a = *(const LAS bf16x8*)(lds + G_K + (16 * si + l15) * 272 + (32 * ks + 8 * lg) * 2);
                  const bf16x8 bq = *(const LAS bf16x8*)(lds + G_Q + (16 * ti + l15) * 272 + (32 * ks + 8 * lg) * 2); acc = MFMA16(a, bq, acc); }
              const int t = 16 * ti + l15, s0 = 16 * si + 4 * lg; float pv[4];
#pragma unroll
              for (int r = 0; r < 4; ++r) { const int s = s0 + r; const bool keep = dir ? (s < t) : (s <= t); pv[r] = keep ? acc[r] : 0.f; }
              *(LAS u32x2*)(lds + G_P + t * 144 + s0 * 2) = (u32x2){pk2(pv[0], pv[1]), pk2(pv[2], pv[3])}; } }
        __syncthreads();
        bf16x8 av[2], as[4];
#pragma unroll
        for (int ks = 0; ks < 2; ++ks) av[ks] = *(const LAS bf16x8*)(lds + G_VT + (16 * wave + l15) * 144 + (32 * ks + 8 * lg) * 2);
#pragma unroll
        for (int ks = 0; ks < 4; ++ks) as[ks] = *(const LAS bf16x8*)(lds + G_ST + (16 * wave + l15) * 272 + (32 * ks + 8 * lg) * 2);
#pragma unroll
        for (int tt = 0; tt < 4; ++tt) { f32x4 acc = (f32x4){0.f, 0.f, 0.f, 0.f};
#pragma unroll
            for (int ks = 0; ks < 2; ++ks) { const bf16x8 bp = *(const LAS bf16x8*)(lds + G_P + (16 * tt + l15) * 144 + (32 * ks + 8 * lg) * 2); acc = MFMA16(av[ks], bp, acc); }
#pragma unroll
            for (int ks = 0; ks < 4; ++ks) { const bf16x8 bq = *(const LAS bf16x8*)(lds + G_Q + (16 * tt + l15) * 272 + (32 * ks + 8 * lg) * 2); acc = MFMA16(as[ks], bq, acc); }
            const size_t tok = GLA_TOK(n, 16 * tt + l15);
            *(u32x2*)(ob + tok * 1024 + h * 256 + vh * 128 + 16 * wave + 4 * lg) = (u32x2){pk2(acc[0], acc[1]), pk2(acc[2], acc[3])}; }
#pragma unroll
        for (int dt = 0; dt < 8; ++dt) { const f32x4 e4 = *(const LAS f32x4*)(lds + G_EBL + (16 * dt + 4 * lg) * 4); st[dt] = st[dt] * e4;
#pragma unroll
            for (int ks = 0; ks < 2; ++ks) { const bf16x8 a = *(const LAS bf16x8*)(lds + G_KE + (16 * dt + l15) * 144 + (32 * ks + 8 * lg) * 2); st[dt] = MFMA16(a, av[ks], st[dt]); }
            *(LAS u32x2*)(lds + G_ST + (16 * wave + l15) * 272 + (16 * dt + 4 * lg) * 2) = (u32x2){pk2(st[dt][0], st[dt][1]), pk2(st[dt][2], st[dt][3])}; }
        __syncthreads();
    }
#undef GLA_LOAD
#undef GLA_TOK
}

constexpr int M_VNT = 0, M_WS = 34816, M_MU = 69632, M_RS = 70144;
__device__ __forceinline__ void gmlp_item(LAS unsigned char* lds, const bf16* __restrict__ gv, bf16* ug, const float* __restrict__ lng, const float* __restrict__ lnb,
                                          const float* __restrict__ wsp, const float* __restrict__ bsp, int item, int tid) {
    const int lane = tid & 63, wave = __builtin_amdgcn_readfirstlane(tid >> 6), l15 = lane & 15, lg = lane >> 4;
    const size_t T0 = (size_t)(item >> 4) * S + (size_t)(item & 15) * 128;
    LAS float* MU = (LAS float*)(lds + M_MU); LAS float* RS = (LAS float*)(lds + M_RS);
    for (int rr0 = 0; rr0 < 16; rr0 += 8) {
        u32x4 x0[8], x1[8];
#pragma unroll
        for (int u = 0; u < 8; ++u) { const u32x4* p = (const u32x4*)(gv + (T0 + 16 * wave + rr0 + u) * 1024); x0[u] = p[lane]; x1[u] = p[64 + lane]; }
#pragma unroll
        for (int u = 0; u < 8; ++u) { float s = 0.f, s2 = 0.f;
#define ACC2(w) do { const float a_ = bf_lo(w), b_ = bf_hi(w); s += a_ + b_; s2 += a_ * a_ + b_ * b_; } while (0)
            ACC2(x0[u].x); ACC2(x0[u].y); ACC2(x0[u].z); ACC2(x0[u].w); ACC2(x1[u].x); ACC2(x1[u].y); ACC2(x1[u].z); ACC2(x1[u].w);
#undef ACC2
            s = wave_sum(s); s2 = wave_sum(s2);
            const float mu = s * (1.0f / 1024.0f), var = fmaxf(s2 * (1.0f / 1024.0f) - mu * mu, 0.f);
            if (lane == 0) { MU[16 * wave + rr0 + u] = mu; RS[16 * wave + rr0 + u] = 1.0f / sqrtf(var + EPS); } }
    }
    u32x4 raw[4]; f32x4 w4[8];
    const int s_ = tid & 127;
#define GM_LOAD(g) do { \
        _Pragma("unroll") for (int i = 0; i < 4; ++i) { const int c8 = (tid >> 7) + 4 * i; raw[i] = *(const u32x4*)(gv + (T0 + s_) * 1024 + 128 * (g) + 8 * c8); } \
        _Pragma("unroll") for (int i = 0; i < 8; ++i) { const int p = tid + 512 * i, t = p >> 5, s4 = p & 31; w4[i] = *(const f32x4*)(wsp + ((size_t)(g) * 128 + t) * 128 + 4 * s4); } } while (0)
    GM_LOAD(0);
    __syncthreads();
    for (int g = 0; g < 8; ++g) {
        { const float mu = MU[s_], rs = RS[s_];
#pragma unroll
          for (int i = 0; i < 4; ++i) { const int c8 = (tid >> 7) + 4 * i;
              const f32x4 g0 = *(const f32x4*)(lng + 128 * g + 8 * c8), g1 = *(const f32x4*)(lng + 128 * g + 8 * c8 + 4), b0 = *(const f32x4*)(lnb + 128 * g + 8 * c8), b1 = *(const f32x4*)(lnb + 128 * g + 8 * c8 + 4);
              LAS unsigned short* vt = (LAS unsigned short*)(lds + M_VNT + (8 * c8) * 272 + 2 * s_);
              vt[0 * 136] = f2bf((bf_lo(raw[i].x) - mu) * rs * g0[0] + b0[0]); vt[1 * 136] = f2bf((bf_hi(raw[i].x) - mu) * rs * g0[1] + b0[1]);
              vt[2 * 136] = f2bf((bf_lo(raw[i].y) - mu) * rs * g0[2] + b0[2]); vt[3 * 136] = f2bf((bf_hi(raw[i].y) - mu) * rs * g0[3] + b0[3]);
              vt[4 * 136] = f2bf((bf_lo(raw[i].z) - mu) * rs * g1[0] + b1[0]); vt[5 * 136] = f2bf((bf_hi(raw[i].z) - mu) * rs * g1[1] + b1[1]);
              vt[6 * 136] = f2bf((bf_lo(raw[i].w) - mu) * rs * g1[2] + b1[2]); vt[7 * 136] = f2bf((bf_hi(raw[i].w) - mu) * rs * g1[3] + b1[3]); } }
#pragma unroll
        for (int i = 0; i < 8; ++i) { const int p = tid + 512 * i, t = p >> 5, s4 = p & 31;
            *(LAS u32x2*)(lds + M_WS + t * 272 + 8 * s4) = (u32x2){pk2(w4[i][0], w4[i][1]), pk2(w4[i][2], w4[i][3])}; }
        if (g + 1 < 8) GM_LOAD(g + 1);
        u32x2 uu[8]; float bias[8];
#pragma unroll
        for (int tt = 0; tt < 8; ++tt) { const int t = 16 * tt + l15; uu[tt] = *(const u32x2*)(ug + (T0 + t) * 1024 + 128 * g + 16 * wave + 4 * lg); bias[tt] = bsp[g * 128 + t]; }
        __syncthreads();
        bf16x8 a[4];
#pragma unroll
        for (int ks = 0; ks < 4; ++ks) a[ks] = *(const LAS bf16x8*)(lds + M_VNT + (16 * wave + l15) * 272 + (32 * ks + 8 * lg) * 2);
#pragma unroll
        for (int tt = 0; tt < 8; ++tt) { f32x4 acc = (f32x4){0.f, 0.f, 0.f, 0.f};
#pragma unroll
            for (int ks = 0; ks < 4; ++ks) { const bf16x8 bw = *(const LAS bf16x8*)(lds + M_WS + (16 * tt + l15) * 272 + (32 * ks + 8 * lg) * 2); acc = MFMA16(a[ks], bw, acc); }
            const int t = 16 * tt + l15;
            *(u32x2*)(ug + (T0 + t) * 1024 + 128 * g + 16 * wave + 4 * lg) = (u32x2){pk2((acc[0] + bias[tt]) * bf_lo(uu[tt].x), (acc[1] + bias[tt]) * bf_hi(uu[tt].x)), pk2((acc[2] + bias[tt]) * bf_lo(uu[tt].y), (acc[3] + bias[tt]) * bf_hi(uu[tt].y))}; }
        __syncthreads();
    }
#undef GM_LOAD
}

constexpr int MISC_OFF = 131072 + 320;
constexpr int CW_BAR = 4096;
constexpr size_t CTL_ZERO_BYTES = 65536;

#define XB_TMO      128
#define XB_XCNT(j)  (256  + 64 * (j))
#define XB_XSUB(j)  (1280 + 64 * (j))
#define XB_XGEN(j)  (2304 + 64 * (j))
#define XB_TOP      3328
#define XB_TOPGEN   3392
#define XCD_BAR_WORDS 3456
#define XB_SPIN_CAP (1u << 18)

__device__ __forceinline__ unsigned xb_ld(unsigned* p)              { return __hip_atomic_load(p, __ATOMIC_RELAXED, __HIP_MEMORY_SCOPE_AGENT); }
__device__ __forceinline__ unsigned xb_add(unsigned* p, unsigned v) { return __hip_atomic_fetch_add(p, v, __ATOMIC_RELAXED, __HIP_MEMORY_SCOPE_AGENT); }
__device__ __forceinline__ unsigned xb_xcc_id() { return (unsigned)__builtin_amdgcn_s_getreg((3 << 11) | 20) & 0xFu; }
#define XB_SPIN(cond, bar) do { unsigned _sp = 0; while (cond) { __builtin_amdgcn_s_sleep(1); \
    if ((++_sp & 255u) == 0u) { if (xb_ld(&(bar)[XB_TMO])) break; if (_sp > XB_SPIN_CAP) { atomicAdd(&(bar)[XB_TMO], 1u); break; } } } } while (0)

struct XcdBarrier {
    unsigned* bar; unsigned x;
    volatile LAS unsigned* st;
};

__device__ __forceinline__ XcdBarrier xcd_barrier_post(unsigned* bar, volatile LAS unsigned* st) {
    XcdBarrier b; b.bar = bar; b.x = xb_xcc_id(); b.st = st;
    if (threadIdx.x == 0) (void)xb_add(&bar[XB_XCNT(b.x)], 1u);
    return b;
}
__device__ __forceinline__ void xcd_barrier_complete(unsigned* bar, unsigned x, unsigned& nloc, unsigned& nx) {
    const unsigned G = gridDim.x * gridDim.y * gridDim.z;
    unsigned sum, cnt, mine, sp = 0u;
    for (;;) {
        sum = 0u; cnt = 0u; mine = 0u;
#pragma unroll
        for (unsigned j = 0; j < 16; ++j) { const unsigned c = xb_ld(&bar[XB_XCNT(j)]); sum += c; cnt += (c > 0u) ? 1u : 0u; mine = (j == x) ? c : mine; }
        if (sum == G) break;
        __builtin_amdgcn_s_sleep(1);
        if ((++sp & 255u) == 0u) { if (xb_ld(&bar[XB_TMO])) break; if (sp > XB_SPIN_CAP) { atomicAdd(&bar[XB_TMO], 1u); break; } }
    }
    nloc = mine > 0u ? mine : 1u; nx = cnt > 0u ? cnt : 1u;
}

__device__ __forceinline__ void xcd_barrier(const XcdBarrier& b) {
    asm volatile("s_waitcnt vmcnt(0)" ::: "memory");
    __syncthreads();
    if (threadIdx.x == 0) {
        unsigned* bar = b.bar;
        __builtin_amdgcn_s_waitcnt(0);
        unsigned nloc = b.st[0], nx = b.st[1];
        if (nloc == 0u) { xcd_barrier_complete(bar, b.x, nloc, nx); b.st[0] = nloc; b.st[1] = nx; }
        const unsigned old = xb_add(&bar[XB_XSUB(b.x)], 1u);
        const unsigned gen = old / nloc;
        if (old + 1u == (gen + 1u) * nloc) {
            __builtin_amdgcn_fence(__ATOMIC_RELEASE, "agent");
            asm volatile("s_waitcnt vmcnt(0)" ::: "memory");
            const unsigned og = xb_add(&bar[XB_TOP], 1u);
            const unsigned tg = og / nx;
            if (og + 1u == (tg + 1u) * nx) xb_add(&bar[XB_TOPGEN], 1u);
            else XB_SPIN(xb_ld(&bar[XB_TOPGEN]) == tg, bar);
            __builtin_amdgcn_fence(__ATOMIC_ACQUIRE, "agent");
            xb_add(&bar[XB_XGEN(b.x)], 1u);
            asm volatile("s_waitcnt vmcnt(0)" ::: "memory");
        } else {
            XB_SPIN(xb_ld(&bar[XB_XGEN(b.x)]) == gen, bar);
            __builtin_amdgcn_fence(__ATOMIC_ACQUIRE, "agent");
            asm volatile("s_waitcnt vmcnt(0)" ::: "memory");
        }
    }
    __syncthreads();
}

#define GRID_SYNC() xcd_barrier(bar)
__global__ void __launch_bounds__(NTHR, 2) fwd_megakernel(Args args) {
    extern __shared__ __attribute__((aligned(16))) unsigned char lds_raw[];
    LAS unsigned char* lds = (LAS unsigned char*)lds_raw;
    if (threadIdx.x < 32) ((LAS unsigned*)(lds + MISC_OFF))[threadIdx.x] = 0u;
    __syncthreads();
    const XcdBarrier bar = xcd_barrier_post((unsigned*)args.ws + CW_BAR, (volatile LAS unsigned*)(lds + MISC_OFF) + 8);
    const int tid = threadIdx.x, lane = tid & 63, wave = __builtin_amdgcn_readfirstlane(tid >> 6);
    const int G = gridDim.x, bx = blockIdx.x;
    const int gw = bx * NWAVES + wave, NGW = G * NWAVES;
    unsigned char* ws = args.ws;
    const float* x = args.in[0]; float* out = args.out;
    float* mod = (float*)(ws + WS_MOD);
    bf16* Win_t = (bf16*)(ws + WS_WIN); bf16* Wg_t = (bf16*)(ws + WS_WG); bf16* Wm_t = (bf16*)(ws + WS_WM); bf16* Wo_t = (bf16*)(ws + WS_WO);
    float* RA = (float*)(ws + WS_RA);
    bf16* Qb = (bf16*)(ws + WS_Q); bf16* Kb = (bf16*)(ws + WS_K); bf16* Vb = (bf16*)(ws + WS_V); bf16* SZ = (bf16*)(ws + WS_SZ); bf16* UG = (bf16*)(ws + WS_UG);
    bf16* GV = (bf16*)(ws + WS_GV); bf16* SMG = (bf16*)(ws + WS_SMG); bf16* SMM = (bf16*)(ws + WS_SMM); bf16* MG = (bf16*)(ws + WS_MG);
    bf16* XN = (bf16*)out; bf16* OFW = (bf16*)out; bf16* OBW = (bf16*)out + (size_t)M * 1024;

    if (bx < 48) p0_mod(lds, args.in[1], args.in[3], args.in[4], mod, bx, tid);
    {
        LAS float* scr = (LAS float*)(lds + wave * 16384);
        constexpr int I_IN = 16 * 264, I_SQ = 16 * 32, NITEMS = I_IN + 3 * I_SQ;
        for (int it = gw; it < NITEMS; it += NGW) {
            int r = it;
            if (r < I_IN) { const int kb = r / 264, db = r % 264, sb = win_src_block(db); transpose_item(args.in[5], NIN_SRC, Win_t, D, 32 * db, sb < 0 ? -1 : 32 * sb, 64 * kb, scr, lane); continue; } r -= I_IN;
            const int w = r / I_SQ; r -= w * I_SQ;
            const float* src = args.in[15 + w]; bf16* dst = w == 0 ? Wg_t : (w == 1 ? Wm_t : Wo_t);
            transpose_item(src, D, dst, D, 32 * (r % 32), 32 * (r % 32), 64 * (r / 32), scr, lane);
        }
    }
    GRID_SYNC();
    {
        const float* ng = args.in[2];
        for (int m0 = gw; m0 < M; m0 += 4 * NGW) {
            f32x4 v[4][4];
#pragma unroll
            for (int u = 0; u < 4; ++u) { if (m0 + u * NGW >= M) break; const f32x4* xr = (const f32x4*)(x + (size_t)(m0 + u * NGW) * D) + lane;
#pragma unroll
                for (int j = 0; j < 4; ++j) v[u][j] = __builtin_nontemporal_load(xr + 64 * j); }
#pragma unroll
            for (int u = 0; u < 4; ++u) { const int m = m0 + u * NGW; if (m >= M) break; const float* mb = mod + (size_t)(m >> 11) * 3072; float ss = 0.f;
#pragma unroll
                for (int j = 0; j < 4; ++j) ss += (v[u][j][0] * v[u][j][0] + v[u][j][1] * v[u][j][1]) + (v[u][j][2] * v[u][j][2] + v[u][j][3] * v[u][j][3]);
                const float r = 1.0f / sqrtf(wave_sum(ss) * (1.0f / D) + EPS);
#pragma unroll
                for (int j = 0; j < 4; ++j) { const int col = 256 * j + 4 * lane; const f32x4 g4 = *(const f32x4*)(ng + col), sc4 = *(const f32x4*)(mb + 1024 + col), sh4 = *(const f32x4*)(mb + col);
                    const f32x4 hv = v[u][j] * r * g4 * (sc4 + 1.0f) + sh4;
                    *(u32x2*)(XN + (size_t)m * D + col) = (u32x2){pk2(hv[0], hv[1]), pk2(hv[2], hv[3])}; } }
        }
    }
    GRID_SYNC();
    {
        pg8::Gemm g{XN, Win_t, M, NINP, D}; pg8::StaticOrder So; So.init(M, NINP, G, bx);
        pg8::EpiIn E{Qb, Kb, Vb, SZ, UG, GV, SMG, SMM, RA};
        pg8::gemm_phase<pg8::EpiIn, pg8::StaticOrder, PG8_ALIGN, PG8_SP2>(lds, g, So, E);
    }
#if REP_P2 > 1
    {
        pg8::Gemm g{XN, Win_t, M, NINP, D}; pg8::StaticOrder So; So.init(M, NINP, G, bx);
        pg8::EpiIn E{Qb, Kb, Vb, SZ, UG, GV, SMG, SMM, RA};
        pg8::gemm_phase<pg8::EpiIn, pg8::StaticOrder, PG8_ALIGN, PG8_SP2>(lds, g, So, E);
    }
#endif
    GRID_SYNC();
    for (int it = bx; it < 256; it += G) {
        const int vh = it & 1, dir = (it >> 1) & 1, h = (it >> 2) & 3, b = it >> 4;
        gla_item(lds, Qb, Kb, Vb, RA, dir ? args.in[8] : args.in[6], dir ? args.in[9] : args.in[7], dir ? OBW : OFW, b, h, dir, vh, tid);
    }
#if REP_GLA > 1
    for (int it = bx; it < 256; it += G) {
        const int vh = it & 1, dir = (it >> 1) & 1, h = (it >> 2) & 3, b = it >> 4;
        gla_item(lds, Qb, Kb, Vb, RA, dir ? args.in[8] : args.in[6], dir ? args.in[9] : args.in[7], dir ? OBW : OFW, b, h, dir, vh, tid);
    }
#endif
    for (int it = bx; it < 256; it += G) gmlp_item(lds, GV, UG, args.in[11], args.in[12], args.in[13], args.in[14], it, tid);
    GRID_SYNC();
    {
        const float* gg = args.in[10];
        const f32x4* gp = (const f32x4*)(gg + 16 * lane); const f32x4 g0 = gp[0], g1 = gp[1], g2 = gp[2], g3 = gp[3];
        const float gs[16] = {g0[0], g0[1], g0[2], g0[3], g1[0], g1[1], g1[2], g1[3], g2[0], g2[1], g2[2], g2[3], g3[0], g3[1], g3[2], g3[3]};
        for (int m0 = gw; m0 < M; m0 += 4 * NGW) {
            u32x4 f0[4], f1[4], b0[4], b1[4], z0[4], z1[4];
#pragma unroll
            for (int u = 0; u < 4; ++u) { const size_t off = (size_t)(m0 + u * NGW) * 1024 + 16 * lane;
                f0[u] = __builtin_nontemporal_load((const u32x4*)(OFW + off)); f1[u] = __builtin_nontemporal_load((const u32x4*)(OFW + off + 8));
                b0[u] = __builtin_nontemporal_load((const u32x4*)(OBW + off)); b1[u] = __builtin_nontemporal_load((const u32x4*)(OBW + off + 8));
                z0[u] = *(const u32x4*)(SZ + off); z1[u] = *(const u32x4*)(SZ + off + 8); }
#pragma unroll
            for (int u = 0; u < 4; ++u) { const size_t off = (size_t)(m0 + u * NGW) * 1024 + 16 * lane;
                float o[16];
#define SUM2(i, fw, bw) o[i] = bf_lo(fw) + bf_lo(bw); o[i + 1] = bf_hi(fw) + bf_hi(bw)
                SUM2(0, f0[u].x, b0[u].x); SUM2(2, f0[u].y, b0[u].y); SUM2(4, f0[u].z, b0[u].z); SUM2(6, f0[u].w, b0[u].w); SUM2(8, f1[u].x, b1[u].x); SUM2(10, f1[u].y, b1[u].y); SUM2(12, f1[u].z, b1[u].z); SUM2(14, f1[u].w, b1[u].w);
#undef SUM2
                float ss = 0.f;
#pragma unroll
                for (int i = 0; i < 16; ++i) ss += o[i] * o[i];
                ss += __shfl_xor(ss, 1); ss += __shfl_xor(ss, 2); ss += __shfl_xor(ss, 4); ss += __shfl_xor(ss, 8);
                const float r = 1.0f / sqrtf(ss * (1.0f / 256.0f) + EPS);
                const unsigned zw[8] = {z0[u].x, z0[u].y, z0[u].z, z0[u].w, z1[u].x, z1[u].y, z1[u].z, z1[u].w};
                unsigned ow[8];
#pragma unroll
                for (int i = 0; i < 8; ++i) ow[i] = pk2(o[2 * i] * r * gs[2 * i] * bf_lo(zw[i]), o[2 * i + 1] * r * gs[2 * i + 1] * bf_hi(zw[i]));
                *(u32x4*)(SZ + off) = (u32x4){ow[0], ow[1], ow[2], ow[3]}; *(u32x4*)(SZ + off + 8) = (u32x4){ow[4], ow[5], ow[6], ow[7]}; }
        }
    }
    GRID_SYNC();
    {
        pg8::StaticOrder So; So.init(M, D, G, bx);
        { pg8::Gemm g{SZ, Wg_t, M, D, D}; pg8::EpiMerge<true> E{SMG, MG}; pg8::gemm_phase<pg8::EpiMerge<true>, pg8::StaticOrder, PG8_ALIGN, PG8_SP2>(lds, g, So, E); }
        { pg8::Gemm g{UG, Wm_t, M, D, D}; pg8::EpiMerge<false> E{SMM, MG}; pg8::gemm_phase<pg8::EpiMerge<false>, pg8::StaticOrder, PG8_ALIGN, PG8_SP2>(lds, g, So, E); }
    }
#if REP_P45 > 1
    {
        pg8::StaticOrder So; So.init(M, D, G, bx);
        { pg8::Gemm g{SZ, Wg_t, M, D, D}; pg8::EpiMerge<true> E{SMG, MG}; pg8::gemm_phase<pg8::EpiMerge<true>, pg8::StaticOrder, PG8_ALIGN, PG8_SP2>(lds, g, So, E); }
        { pg8::Gemm g{UG, Wm_t, M, D, D}; pg8::EpiMerge<false> E{SMM, MG}; pg8::gemm_phase<pg8::EpiMerge<false>, pg8::StaticOrder, PG8_ALIGN, PG8_SP2>(lds, g, So, E); }
    }
#endif
    GRID_SYNC();
    {
        pg8::Gemm g{MG, Wo_t, M, D, D}; pg8::StaticOrder So; So.init(M, D, G, bx);
        pg8::EpiOut E{x, mod + 2048, out};
        pg8::gemm_phase<pg8::EpiOut, pg8::StaticOrder, PG8_ALIGN, PG8_SP2>(lds, g, So, E);
    }
#if REP_P45 > 1
    {
        pg8::Gemm g{MG, Wo_t, M, D, D}; pg8::StaticOrder So; So.init(M, D, G, bx);
        pg8::EpiOut E{x, mod + 2048, out};
        pg8::gemm_phase<pg8::EpiOut, pg8::StaticOrder, PG8_ALIGN, PG8_SP2>(lds, g, So, E);
    }
#endif
    GRID_SYNC();
#ifdef PROBE_SYNC
    GRID_SYNC(); GRID_SYNC(); GRID_SYNC(); GRID_SYNC(); GRID_SYNC(); GRID_SYNC(); GRID_SYNC();
#endif
    {
        const float* fg = args.in[18];
        f32x4 g4[4];
#pragma unroll
        for (int j = 0; j < 4; ++j) g4[j] = *(const f32x4*)(fg + 256 * j + 4 * lane);
        for (int m0 = gw; m0 < M; m0 += 4 * NGW) {
            f32x4 v[4][4];
#pragma unroll
            for (int u = 0; u < 4; ++u) { const f32x4* xr = (const f32x4*)(out + (size_t)(m0 + u * NGW) * D) + lane;
#pragma unroll
                for (int j = 0; j < 4; ++j) v[u][j] = xr[64 * j]; }
#pragma unroll
            for (int u = 0; u < 4; ++u) { f32x4* xr = (f32x4*)(out + (size_t)(m0 + u * NGW) * D) + lane; float ss = 0.f;
#pragma unroll
                for (int j = 0; j < 4; ++j) ss += (v[u][j][0] * v[u][j][0] + v[u][j][1] * v[u][j][1]) + (v[u][j][2] * v[u][j][2] + v[u][j][3] * v[u][j][3]);
                const float r = 1.0f / sqrtf(wave_sum(ss) * (1.0f / D) + EPS);
#pragma unroll
                for (int j = 0; j < 4; ++j) xr[64 * j] = v[u][j] * r * g4[j]; }
        }
    }
}

extern "C" void kernel_launch(void* const* d_in, const int* in_sizes, int n_in, void* d_out, int out_size, void* d_ws, size_t ws_size, hipStream_t stream) {
    static int grid = 0;
    if (grid == 0) {
        if (n_in != 19 || in_sizes[0] != M * D || out_size != M * D || ws_size < WS_END) { fprintf(stderr, "kernel_launch: unexpected shapes (n_in %d, in0 %d, out %d, ws %zu); nothing launched\n", n_in, n_in > 0 ? in_sizes[0] : -1, out_size, ws_size); grid = -1; return; }
        int dev = 0, cus = 0, per_cu = 0;
        if (hipGetDevice(&dev) != hipSuccess || hipDeviceGetAttribute(&cus, hipDeviceAttributeMultiprocessorCount, dev) != hipSuccess) { grid = -1; return; }
        if (hipFuncSetAttribute((const void*)fwd_megakernel, hipFuncAttributeMaxDynamicSharedMemorySize, LDS_BYTES) != hipSuccess) { fprintf(stderr, "kernel_launch: hipFuncSetAttribute failed\n"); grid = -1; return; }
        if (hipOccupancyMaxActiveBlocksPerMultiprocessor(&per_cu, (const void*)fwd_megakernel, NTHR, LDS_BYTES) != hipSuccess || per_cu < 1) { fprintf(stderr, "kernel_launch: occupancy query says %d blocks per CU; nothing launched\n", per_cu); (void)hipGetLastError(); grid = -1; return; }
        grid = cus * (per_cu < 1 ? 1 : 1);
    }
    if (grid < 0) return;
    if (hipMemsetAsync(d_ws, 0, CTL_ZERO_BYTES, stream) != hipSuccess) { fprintf(stderr, "kernel_launch: hipMemsetAsync failed; nothing launched\n"); return; }
    Args a{};
    for (int i = 0; i < 19; ++i) a.in[i] = (const float*)d_in[i];
    a.out = (float*)d_out; a.ws = (unsigned char*)d_ws;
    void* kargs[] = {&a};
    const hipError_t e = hipLaunchCooperativeKernel((const void*)fwd_megakernel, dim3(grid), dim3(NTHR), kargs, LDS_BYTES, stream);
    if (e != hipSuccess) fprintf(stderr, "kernel_launch: cooperative launch failed: %s (grid %d)\n", hipGetErrorString(e), grid);
}
```

```cpp
#include <hip/hip_runtime.h>
#include <hip/hip_cooperative_groups.h>
#include <cstdio>
#include <cstdint>
namespace cg = cooperative_groups;
namespace pg8 {
#define PG8_LAS __attribute__((address_space(3)))
typedef unsigned short bf16_t;
typedef short bf16x8 __attribute__((ext_vector_type(8)));
typedef float f32x4 __attribute__((ext_vector_type(4)));
typedef unsigned u32x4 __attribute__((ext_vector_type(4)));
constexpr int BM = 256, BK = 64, HALF = 128, HTB = HALF * BK * 2  , STAGE_BYTES = 8 * HTB, NXCD = 8, WGM = 8;

__host__ __device__ __forceinline__ int lds_byte(int r, int c) { const int st = (r >> 4) * 2 + (c >> 5), rr = r & 15, cc = c & 31, ob = rr * 64 + cc * 2; return st * 1024 + (ob ^ (((ob >> 9) & 1) << 5)); }
__host__ __device__ __forceinline__ void stage_rc(int b, int& R, int& C) { const int st = b / 1024, sb = b % 1024, swz = sb ^ (((sb >> 9) & 1) << 5); R = (st >> 1) * 16 + swz / 64; C = (st & 1) * 32 + (swz % 64) / 2; }
__host__ __device__ __forceinline__ int perm32(int rho) { const int n = rho >> 4, i = rho & 15; return 8 * (i >> 2) + 4 * n + (i & 3); }

struct Unit { int pm, pn; };
struct Gemm { const bf16_t* A; const bf16_t* Bt; int M, N, K; };

struct StaticOrder {
    int nM, nN, nwg, G, c;
    __host__ __device__ void init(int M, int N, int G_, int c_) { nM = M / BM; nN = N / BM; nwg = nM * nN; G = G_; c = c_; }
    __host__ __device__ bool next(int i, Unit& u) const {
        const long L = (long)i * G + c; if (L >= nwg) return false;
        int wgid = (int)L; { const int q = nwg / NXCD, r = nwg % NXCD, xcd = wgid % NXCD, off = wgid / NXCD; wgid = (xcd < r ? xcd * (q + 1) : r * (q + 1) + (xcd - r) * q) + off; }
        const int nig = WGM * nN, gid = wgid / nig, fm = gid * WGM, gsz = (nM - fm) < WGM ? (nM - fm) : WGM;
        u.pm = fm + ((wgid % nig) % gsz); u.pn = (wgid % nig) / gsz; return true;
    }
    __device__ __forceinline__ void a_ready(const Unit&) const {}
    __device__ __forceinline__ void done(const Unit&) const {}
};

typedef float f32x2c_t __attribute__((ext_vector_type(2)));
typedef __bf16 bf16x2c_t __attribute__((ext_vector_type(2)));
__device__ __forceinline__ unsigned cvt_pk_bf16(float lo, float hi) { const f32x2c_t v = {lo, hi}; const bf16x2c_t b = __builtin_convertvector(v, bf16x2c_t); return __builtin_bit_cast(unsigned, b); }
typedef float f32x2 __attribute__((ext_vector_type(2)));
__device__ __forceinline__ f32x2 gelu_pk(f32x2 v) {
    const f32x2 av = __builtin_elementwise_abs(v), d = av * 0.2316418882f + 1.0f;
    f32x2 t; t.x = __builtin_amdgcn_rcpf(d.x); t.y = __builtin_amdgcn_rcpf(d.y);
    f32x2 q = t * 0.5307027145f + (-0.7265760135f); q = q * t + 0.7107068705f; q = q * t + (-0.142248368f); q = q * t + 0.127414796f; q = q * t;
    const f32x2 s = (v * v) * (-0.72134752044f);
    f32x2 e; e.x = __builtin_amdgcn_exp2f(s.x); e.y = __builtin_amdgcn_exp2f(s.y);
    const f32x2 m = v * (q * e), r = v - m;
    f32x2 o; o.x = v.x < 0.f ? m.x : r.x; o.y = v.y < 0.f ? m.y : r.y; return o;
}

template <class Epi, class Sched, bool ALIGN_EPI = false, bool SP2 = false>
__device__ __forceinline__ void gemm_phase(PG8_LAS unsigned char* lds, const Gemm g, const Sched& S, const Epi& E) {
    const int tid = threadIdx.x, wid = __builtin_amdgcn_readfirstlane(tid >> 6), lane = tid & 63, wr = wid >> 2, wc = wid & 3, fr = lane & 15, fq = lane >> 4;
    const int K = g.K, nt = K / BK;
    unsigned voffA[2], voffB[2];
#pragma unroll
    for (int i = 0; i < 2; ++i) { int R, C; stage_rc(tid * 16 + i * 8192, R, C); const int Rb = Epi::PERM ? ((R & ~31) + perm32(R & 31)) : R;
        voffA[i] = (unsigned)(R * K + C) * 2u; voffB[i] = (unsigned)(Rb * K + C) * 2u; }
    const size_t kstep = (size_t)(BK * 2);
    const size_t hstep = (size_t)HALF * K * 2;
    const size_t tstep = 2 * hstep;
    const unsigned ldsw = (unsigned)wid * 1024u;
    const int aoff = lds_byte(wr * 64 + fr, fq * 8), boff = lds_byte(wc * 32 + fr, fq * 8);
#define PG8_SA(b, h) (((b) * 2 + (h)) * HTB)
#define PG8_SB(b, h) ((4 + (b) * 2 + (h)) * HTB)
#define PG8_STAGE(bufoff, gbase, voff) do { _Pragma("unroll") for (int _i = 0; _i < 2; ++_i) \
        __builtin_amdgcn_global_load_lds((const unsigned*)((const char*)(gbase) + (voff)[_i]), (PG8_LAS unsigned*)(lds + (bufoff) + ldsw + _i * 8192), 16, 0, 0); } while (0)
#define PG8_LDA(dst, b, h) do { _Pragma("unroll") for (int m = 0; m < 4; ++m) _Pragma("unroll") for (int k = 0; k < 2; ++k) dst[m][k] = *(const PG8_LAS bf16x8*)(lds + PG8_SA(b, h) + aoff + m * 2048 + k * 1024); } while (0)
#define PG8_LDB(dst, b, h) do { _Pragma("unroll") for (int n = 0; n < 2; ++n) _Pragma("unroll") for (int k = 0; k < 2; ++k) dst[n][k] = *(const PG8_LAS bf16x8*)(lds + PG8_SB(b, h) + boff + n * 2048 + k * 1024); } while (0)
#define PG8_MMA(ai, bj, At, Bt) do { __builtin_amdgcn_s_setprio(1); _Pragma("unroll") for (int m = 0; m < 4; ++m) _Pragma("unroll") for (int n = 0; n < 2; ++n) _Pragma("unroll") for (int k = 0; k < 2; ++k) \
        acc[ai][bj][m][n] = __builtin_amdgcn_mfma_f32_16x16x32_bf16(Bt[n][k], At[m][k], acc[ai][bj][m][n], 0, 0, 0); __builtin_amdgcn_s_setprio(0); } while (0)
#define PG8_WAIT_V(n) asm volatile("s_waitcnt vmcnt(" #n ")" ::: "memory")
#define PG8_WAIT_L(n) asm volatile("s_waitcnt lgkmcnt(" #n ")" ::: "memory")
#define PG8_BAR __builtin_amdgcn_s_barrier()
#define PG8_SCHED __builtin_amdgcn_sched_barrier(0)
    Unit cur, nxt; int ui = 0;
    if (!S.next(0, cur)) return;
    f32x4 acc[2][2][4][2];
#pragma unroll
    for (int a = 0; a < 2; ++a)
#pragma unroll
        for (int b = 0; b < 2; ++b)
#pragma unroll
            for (int m = 0; m < 4; ++m)
#pragma unroll
                for (int n = 0; n < 2; ++n) acc[a][b][m][n] = (f32x4){0.f, 0.f, 0.f, 0.f};
    bf16x8 At[4][2], B0[2][2], B1[2][2];
    const char* cA = (const char*)g.A + (size_t)cur.pm * tstep; const char* cB = (const char*)g.Bt + (size_t)cur.pn * tstep;
    S.a_ready(cur);
    if constexpr (SP2) {
        PG8_STAGE(PG8_SB(0, 0), cB, voffB); PG8_STAGE(PG8_SB(0, 1), cB + hstep, voffB); PG8_STAGE(PG8_SA(0, 0), cA, voffA); PG8_STAGE(PG8_SA(0, 1), cA + hstep, voffA);
        if (wr == 1) PG8_BAR;
        PG8_WAIT_V(2); PG8_BAR;
        PG8_STAGE(PG8_SB(1, 0), cB + kstep, voffB); PG8_STAGE(PG8_SA(1, 0), cA + kstep, voffA); PG8_STAGE(PG8_SB(1, 1), cB + hstep + kstep, voffB);
        PG8_WAIT_V(6); PG8_BAR;
    } else {
        PG8_STAGE(PG8_SB(0, 0), cB, voffB); PG8_STAGE(PG8_SA(0, 0), cA, voffA); PG8_STAGE(PG8_SB(0, 1), cB + hstep, voffB); PG8_STAGE(PG8_SA(0, 1), cA + hstep, voffA);
        if (wr == 1) PG8_BAR;
        PG8_WAIT_V(4); PG8_BAR;
        PG8_STAGE(PG8_SB(1, 0), cB + kstep, voffB); PG8_STAGE(PG8_SA(1, 0), cA + kstep, voffA); PG8_STAGE(PG8_SB(1, 1), cB + hstep + kstep, voffB);
        PG8_WAIT_V(6); PG8_BAR;
    }
    for (;;) {
        const bool has_next = S.next(ui + 1, nxt);
        const char* nA = has_next ? (const char*)g.A + (size_t)nxt.pm * tstep : cA; const char* nB = has_next ? (const char*)g.Bt + (size_t)nxt.pn * tstep : cB;
        for (int t = 0; t < nt; t += 2) {
            const bool last = (t == nt - 2);
            const char* a1 = cA + (size_t)(t + 1) * kstep;
            const char* a2 = last ? nA : cA + (size_t)(t + 2) * kstep; const char* b2 = last ? nB : cB + (size_t)(t + 2) * kstep;
            const char* a3 = a2 + kstep; const char* b3 = b2 + kstep;
            if (last && has_next) S.a_ready(nxt);
            if constexpr (SP2) {
            PG8_LDB(B0, 0, 0); PG8_LDB(B1, 0, 1); PG8_SCHED; PG8_LDA(At, 0, 0); PG8_STAGE(PG8_SA(1, 1), a1 + hstep, voffA);
            PG8_WAIT_V(8); PG8_WAIT_L(0); PG8_BAR; PG8_MMA(0, 0, At, B0); PG8_MMA(0, 1, At, B1); PG8_BAR; PG8_SCHED;
            PG8_LDA(At, 0, 1); PG8_STAGE(PG8_SB(0, 0), b2, voffB); PG8_STAGE(PG8_SB(0, 1), b2 + hstep, voffB); PG8_STAGE(PG8_SA(0, 0), a2, voffA);
            PG8_WAIT_V(8); PG8_WAIT_L(0); PG8_BAR; PG8_MMA(1, 0, At, B0); PG8_MMA(1, 1, At, B1); PG8_BAR; PG8_SCHED;
            PG8_LDB(B0, 1, 0); PG8_LDB(B1, 1, 1); PG8_SCHED; PG8_LDA(At, 1, 0); PG8_STAGE(PG8_SA(0, 1), a2 + hstep, voffA);
            PG8_WAIT_V(8); PG8_WAIT_L(0); PG8_BAR; PG8_MMA(0, 0, At, B0); PG8_MMA(0, 1, At, B1); PG8_BAR; PG8_SCHED;
            PG8_LDA(At, 1, 1); PG8_STAGE(PG8_SB(1, 0), b3, voffB); PG8_STAGE(PG8_SB(1, 1), b3 + hstep, voffB); PG8_STAGE(PG8_SA(1, 0), a3, voffA);
            PG8_WAIT_V(8); PG8_WAIT_L(0); PG8_BAR; PG8_MMA(1, 0, At, B0); PG8_MMA(1, 1, At, B1); PG8_BAR; PG8_SCHED;
            } else {
            PG8_LDB(B0, 0, 0); PG8_SCHED; PG8_LDA(At, 0, 0); PG8_STAGE(PG8_SA(1, 1), a1 + hstep, voffA);
            PG8_WAIT_L(8); PG8_BAR; PG8_WAIT_L(0); PG8_MMA(0, 0, At, B0); PG8_BAR; PG8_SCHED;
            PG8_LDB(B1, 0, 1); PG8_STAGE(PG8_SB(0, 0), b2, voffB);
            PG8_BAR; PG8_WAIT_L(0); PG8_MMA(0, 1, At, B1); PG8_BAR;
            PG8_LDA(At, 0, 1); PG8_STAGE(PG8_SA(0, 0), a2, voffA);
            PG8_BAR; PG8_WAIT_L(0); PG8_MMA(1, 0, At, B0); PG8_BAR; PG8_SCHED;
            PG8_STAGE(PG8_SB(0, 1), b2 + hstep, voffB);
            PG8_WAIT_V(6); PG8_BAR; PG8_MMA(1, 1, At, B1); PG8_BAR;
            PG8_LDB(B0, 1, 0); PG8_SCHED; PG8_LDA(At, 1, 0); PG8_STAGE(PG8_SA(0, 1), a2 + hstep, voffA);
            PG8_WAIT_L(8); PG8_BAR; PG8_WAIT_L(0); PG8_MMA(0, 0, At, B0); PG8_BAR; PG8_SCHED;
            PG8_LDB(B1, 1, 1); PG8_STAGE(PG8_SB(1, 0), b3, voffB);
            PG8_BAR; PG8_WAIT_L(0); PG8_MMA(0, 1, At, B1); PG8_BAR;
            PG8_LDA(At, 1, 1); PG8_STAGE(PG8_SA(1, 0), a3, voffA);
            PG8_BAR; PG8_WAIT_L(0); PG8_MMA(1, 0, At, B0); PG8_BAR; PG8_SCHED;
            PG8_STAGE(PG8_SB(1, 1), b3 + hstep, voffB);
            PG8_WAIT_V(6); PG8_BAR; PG8_MMA(1, 1, At, B1); PG8_BAR;
            }
        }
        if constexpr (ALIGN_EPI) { if (wr == 0) PG8_BAR; }
        if constexpr (!Epi::AFTER_DRAIN) { E(acc, cur, wr, wc, fr, fq); S.done(cur); }
        if (!has_next) break;
#pragma unroll
        for (int a = 0; a < 2; ++a)
#pragma unroll
            for (int b = 0; b < 2; ++b)
#pragma unroll
                for (int m = 0; m < 4; ++m)
#pragma unroll
                    for (int n = 0; n < 2; ++n) acc[a][b][m][n] = (f32x4){0.f, 0.f, 0.f, 0.f};
        cur = nxt; cA = nA; cB = nB; ++ui;
        if constexpr (ALIGN_EPI) { if (wr == 1) PG8_BAR; }
    }
    PG8_WAIT_V(0);
    if constexpr (!ALIGN_EPI) { if (wr == 0) PG8_BAR; }
    PG8_BAR;
    if constexpr (Epi::AFTER_DRAIN) { E.fused(acc, cur, wr, wc, fr, fq, lds, wid, lane); S.done(cur); }
#undef PG8_SA
#undef PG8_SB
#undef PG8_STAGE
#undef PG8_LDA
#undef PG8_LDB
#undef PG8_MMA
#undef PG8_WAIT_V
#undef PG8_WAIT_L
#undef PG8_BAR
#undef PG8_SCHED
}
__device__ __forceinline__ float fsigmoid(float x) { return __builtin_amdgcn_rcpf(1.0f + __expf(-x)); }
__device__ __forceinline__ float fsilu(float x) { return x * fsigmoid(x); }
__device__ __forceinline__ f32x4 gelu4(f32x4 v) { const f32x2 a = gelu_pk((f32x2){v[0], v[1]}), b = gelu_pk((f32x2){v[2], v[3]}); return (f32x4){a.x, a.y, b.x, b.y}; }
__device__ __forceinline__ f32x4 silu4(f32x4 v) { return (f32x4){fsilu(v[0]), fsilu(v[1]), fsilu(v[2]), fsilu(v[3])}; }
__device__ __forceinline__ f32x4 sigm4(f32x4 v) { return (f32x4){fsigmoid(v[0]), fsigmoid(v[1]), fsigmoid(v[2]), fsigmoid(v[3])}; }
__device__ __forceinline__ f32x4 act4(int act, f32x4 v, float sc) {
    if (act == 0) return v * sc;
    if (act == 1) return silu4(v);
    if (act == 2) return gelu4(v);
    return sigm4(v);
}
__device__ __forceinline__ u32x4 pack8(f32x4 v0, f32x4 v1) { u32x4 w; w.x = cvt_pk_bf16(v0[0], v0[1]); w.y = cvt_pk_bf16(v0[2], v0[3]); w.z = cvt_pk_bf16(v1[0], v1[1]); w.w = cvt_pk_bf16(v1[2], v1[3]); return w; }
__device__ __forceinline__ float bf_lo(unsigned w) { return __uint_as_float(w << 16); }
__device__ __forceinline__ float bf_hi(unsigned w) { return __uint_as_float(w & 0xffff0000u); }

struct EpiIn {
    static constexpr bool PERM = true, AFTER_DRAIN = false;
    bf16_t *q, *k, *v, *sz, *ug, *gv, *smg, *smm; float* ra;
    __device__ __forceinline__ void operator()(const f32x4 (&acc)[2][2][4][2], const Unit& u, int wr, int wc, int fr, int fq) const {
        const int pn = u.pn, row0 = u.pm * BM + wr * 64 + fr, cw = wc * 32 + 8 * fq;
        if (pn == 32) {
            if (wc == 0) {
#pragma unroll
                for (int ai = 0; ai < 2; ++ai)
#pragma unroll
                    for (int m = 0; m < 4; ++m) { float* rp = ra + (size_t)(row0 + ai * HALF + m * 16) * 32 + 8 * fq; *(f32x4*)rp = acc[ai][0][m][0]; *(f32x4*)(rp + 4) = acc[ai][0][m][1]; }
            }
            return;
        }
        if (pn >= 12 && pn < 20) {
            const int T = pn - 12;
#pragma unroll
            for (int ai = 0; ai < 2; ++ai)
#pragma unroll
                for (int m = 0; m < 4; ++m) { bf16_t* rp = ug + (size_t)(row0 + ai * HALF + m * 16) * 1024 + 128 * T + cw;
                    const f32x4 a0 = gelu4(acc[ai][0][m][0]) * silu4(acc[ai][1][m][0]), a1 = gelu4(acc[ai][0][m][1]) * silu4(acc[ai][1][m][1]);
                    *(u32x4*)rp = pack8(a0, a1); }
            return;
        }
        bf16_t* base; int ld = 1024, colt, act; float sc = 1.f;
        if (pn < 2) { base = q; ld = 512; colt = pn * 256; act = 0; sc = 0.08838834764831845f; }
        else if (pn < 4) { base = k; ld = 512; colt = (pn - 2) * 256; act = 0; }
        else if (pn < 8) { base = v; colt = (pn - 4) * 256; act = 0; }
        else if (pn < 12) { base = sz; colt = (pn - 8) * 256; act = 1; }
        else if (pn < 24) { base = gv; colt = (pn - 20) * 256; act = 2; }
        else if (pn < 28) { base = smg; colt = (pn - 24) * 256; act = 3; }
        else { base = smm; colt = (pn - 28) * 256; act = 3; }
#pragma unroll
        for (int ai = 0; ai < 2; ++ai)
#pragma unroll
            for (int m = 0; m < 4; ++m) { bf16_t* rp = base + (size_t)(row0 + ai * HALF + m * 16) * ld + colt + cw;
#pragma unroll
                for (int bj = 0; bj < 2; ++bj) *(u32x4*)(rp + bj * HALF) = pack8(act4(act, acc[ai][bj][m][0], sc), act4(act, acc[ai][bj][m][1], sc)); }
    }
};
template <bool FIRST> struct EpiMerge {
    static constexpr bool PERM = true, AFTER_DRAIN = false;
    const bf16_t* gate; bf16_t* mg;
    __device__ __forceinline__ void operator()(const f32x4 (&acc)[2][2][4][2], const Unit& u, int wr, int wc, int fr, int fq) const {
        const int row0 = u.pm * BM + wr * 64 + fr, c0 = u.pn * BM + wc * 32 + 8 * fq;
#pragma unroll
        for (int ai = 0; ai < 2; ++ai)
#pragma unroll
            for (int m = 0; m < 4; ++m)
#pragma unroll
                for (int bj = 0; bj < 2; ++bj) { const size_t off = (size_t)(row0 + ai * HALF + m * 16) * 1024 + c0 + bj * HALF;
                    const u32x4 g = *(const u32x4*)(gate + off);
                    f32x4 v0 = acc[ai][bj][m][0] * (f32x4){bf_lo(g.x), bf_hi(g.x), bf_lo(g.y), bf_hi(g.y)}, v1 = acc[ai][bj][m][1] * (f32x4){bf_lo(g.z), bf_hi(g.z), bf_lo(g.w), bf_hi(g.w)};
                    if (!FIRST) { const u32x4 p = *(const u32x4*)(mg + off); v0 += (f32x4){bf_lo(p.x), bf_hi(p.x), bf_lo(p.y), bf_hi(p.y)}; v1 += (f32x4){bf_lo(p.z), bf_hi(p.z), bf_lo(p.w), bf_hi(p.w)}; }
                    *(u32x4*)(mg + off) = pack8(v0, v1); }
    }
};
struct EpiOut {
    static constexpr bool PERM = false, AFTER_DRAIN = false;
    const float* x; const float* gate; float* out;
    __device__ __forceinline__ void operator()(const f32x4 (&acc)[2][2][4][2], const Unit& u, int wr, int wc, int fr, int fq) const {
        const int row0 = u.pm * BM + wr * 64 + fr, c0 = u.pn * BM + wc * 32 + 4 * fq;
#pragma unroll
        for (int ai = 0; ai < 2; ++ai)
#pragma unroll
            for (int m = 0; m < 4; ++m) { const int row = row0 + ai * HALF + m * 16; const float* gp = gate + (size_t)(row >> 11) * 3072;
#pragma unroll
                for (int bj = 0; bj < 2; ++bj)
#pragma unroll
                    for (int n = 0; n < 2; ++n) { const int c = c0 + bj * HALF + 16 * n; const size_t off = (size_t)row * 1024 + c;
                        *(f32x4*)(out + off) = *(const f32x4*)(x + off) + *(const f32x4*)(gp + c) * acc[ai][bj][m][n]; } }
    }
};
}

#ifndef REP_P2
#define REP_P2 1
#endif
#ifndef REP_GLA
#define REP_GLA 1
#endif
#ifndef REP_P45
#define REP_P45 1
#endif
#ifndef PG8_SP2
#define PG8_SP2 true
#endif
#ifndef PG8_ALIGN
#define PG8_ALIGN true
#endif
#define LAS __attribute__((address_space(3)))
typedef unsigned short bf16;
typedef float f32x4 __attribute__((ext_vector_type(4)));
typedef short bf16x8 __attribute__((ext_vector_type(8)));
typedef unsigned u32x4 __attribute__((ext_vector_type(4)));
typedef unsigned u32x2 __attribute__((ext_vector_type(2)));
constexpr int NWAVES = 8, NTHR = 512;
constexpr int D = 1024, NB = 16, S = 2048, M = NB * S, NINP = 8448  , NIN_SRC = 8224;
constexpr float EPS = 1e-6f;
constexpr size_t MiB = 1u << 20;
constexpr size_t WS_MOD = 1 * MiB;
constexpr size_t WS_WIN = 2 * MiB, WS_WG = 19 * MiB, WS_WM = 21 * MiB, WS_WO = 23 * MiB;
constexpr size_t WS_RA = 26 * MiB;
constexpr size_t WS_Q = 32 * MiB, WS_K = 64 * MiB, WS_V = 96 * MiB, WS_SZ = 160 * MiB, WS_UG = 224 * MiB, WS_GV = 288 * MiB, WS_SMG = 352 * MiB, WS_SMM = 416 * MiB, WS_END = 480 * MiB;
constexpr size_t WS_MG = WS_Q;
constexpr int LDS_BYTES = 163840;

__device__ __forceinline__ unsigned pk2(float lo, float hi) { return pg8::cvt_pk_bf16(lo, hi); }
__device__ __forceinline__ float bf_lo(unsigned w) { return __uint_as_float(w << 16); }
__device__ __forceinline__ float bf_hi(unsigned w) { return __uint_as_float(w & 0xffff0000u); }
__device__ __forceinline__ float bf2f(unsigned short h) { return __uint_as_float((unsigned)h << 16); }
__device__ __forceinline__ unsigned short f2bf(float f) { return (unsigned short)(pk2(f, 0.f) & 0xffffu); }
__device__ __forceinline__ float wave_sum(float v) {
#pragma unroll
    for (int o = 1; o < 64; o <<= 1) v += __shfl_xor(v, o);
    return v;
}
#define MFMA16(a, b, c) __builtin_amdgcn_mfma_f32_16x16x32_bf16((a), (b), (c), 0, 0, 0)

__device__ __forceinline__ void p0_mod(LAS unsigned char* lds, const float* c, const float* w_ada, const float* b_ada, float* mod, int blk, int tid) {
    LAS float* sc = (LAS float*)lds;
    LAS float* red = (LAS float*)(lds + 65536);
    for (int i = tid; i < NB * D; i += NTHR) { const float v = c[i]; sc[(i & (D - 1)) * 16 + (i >> 10)] = v / (1.0f + __expf(-v)); }
    __syncthreads();
    const int wave = tid >> 6, lane = tid & 63, col = 64 * blk + lane;
    float acc[16];
#pragma unroll
    for (int b = 0; b < 16; ++b) acc[b] = 0.f;
    for (int k0 = 0; k0 < 128; k0 += 32) {
        float w[32];
#pragma unroll
        for (int j = 0; j < 32; ++j) w[j] = w_ada[(size_t)(wave * 128 + k0 + j) * 3072 + col];
#pragma unroll
        for (int j = 0; j < 32; ++j) { const LAS f32x4* sp = (const LAS f32x4*)(sc + (wave * 128 + k0 + j) * 16);
#pragma unroll
            for (int q = 0; q < 4; ++q) { const f32x4 s4 = sp[q]; acc[4 * q] += s4[0] * w[j]; acc[4 * q + 1] += s4[1] * w[j]; acc[4 * q + 2] += s4[2] * w[j]; acc[4 * q + 3] += s4[3] * w[j]; } }
    }
#pragma unroll
    for (int b = 0; b < 16; ++b) red[(wave * 16 + b) * 64 + lane] = acc[b];
    __syncthreads();
    for (int o = tid; o < 1024; o += NTHR) { const int b = o >> 6, l = o & 63; float s = b_ada[64 * blk + l];
#pragma unroll
        for (int w = 0; w < 8; ++w) s += red[(w * 16 + b) * 64 + l];
        mod[(size_t)b * 3072 + 64 * blk + l] = s; }
    __syncthreads();
}
__device__ __forceinline__ void transpose_item(const float* W, int Nsrc, bf16* WT, int K, int dst_row0, int src_col0, int k0, LAS float* scr, int lane) {
    if (src_col0 >= 0) {
        float t[32];
#pragma unroll
        for (int i = 0; i < 32; ++i) { const int kk = 2 * i + (lane >> 5); t[i] = W[(size_t)(k0 + kk) * Nsrc + src_col0 + (lane & 31)]; }
#pragma unroll
        for (int i = 0; i < 32; ++i) { const int kk = 2 * i + (lane >> 5); scr[kk * 33 + (lane & 31)] = t[i]; }
    } else {
#pragma unroll 8
        for (int i = 0; i < 32; ++i) { const int kk = 2 * i + (lane >> 5); scr[kk * 33 + (lane & 31)] = 0.f; }
    }
    asm volatile("s_waitcnt vmcnt(0) lgkmcnt(0)" ::: "memory");
    const int c = lane & 7;
#pragma unroll
    for (int j = 0; j < 4; ++j) { const int n = (lane >> 3) + 8 * j; const LAS float* s = scr + (8 * c) * 33 + n;
        u32x4 o; o.x = pk2(s[0 * 33], s[1 * 33]); o.y = pk2(s[2 * 33], s[3 * 33]); o.z = pk2(s[4 * 33], s[5 * 33]); o.w = pk2(s[6 * 33], s[7 * 33]);
        *(u32x4*)(WT + (size_t)(dst_row0 + n) * K + k0 + 8 * c) = o; }
    asm volatile("s_waitcnt lgkmcnt(0)" ::: "memory");
}
__device__ __forceinline__ int win_src_block(int db) {
    if (db < 96) return db;
    if (db < 160) { const int T = (db - 96) >> 3, r = (db - 96) & 7; return r < 4 ? 97 + 4 * T + r : 161 + 4 * T + (r - 4); }
    if (db < 192) return 129 + (db - 160);
    if (db < 224) return 193 + (db - 192);
    if (db < 256) return 225 + (db - 224);
    if (db == 256) return 96;
    return -1;
}

struct Args {
    const float* in[19]; float* out; unsigned char* ws;
};

constexpr int G_Q0 = 0, G_K0 = 17408, G_QKB = 34816  , G_KT0 = 69632, G_KTB = 18432, G_VT = 106496, G_P = 124928, G_RA = 134144, G_EBL0 = 138240, G_EBLB = 512, G_OS = 139264  , G_END = 156672;
static_assert(G_END <= LDS_BYTES - 128, "GLA LDS map");
#define DPP_ROW_SHR(x, n) __builtin_bit_cast(float, __builtin_amdgcn_update_dpp(0, __builtin_bit_cast(int, (x)), 0x110 + (n), 0xf, 0xf, true))
__device__ __forceinline__ void gla_A(LAS unsigned char* lds, int buf, const bf16x8 awf, const float (&abv)[4], int wave, int lane, int l15, int lg) {
    constexpr float LOG2E = 1.4426950408889634f;
    LAS unsigned char* Qb_ = lds + G_Q0 + buf * G_QKB; LAS unsigned char* Kb_ = lds + G_K0 + buf * G_QKB; LAS unsigned char* KTb = lds + G_KT0 + buf * G_KTB;
    float b2[4][4];
#pragma unroll
    for (int tt = 0; tt < 4; ++tt) { const bf16x8 bfr = *(const LAS bf16x8*)(lds + G_RA + (16 * tt + l15) * 64 + 16 * lg);
        const f32x4 zz = MFMA16(awf, bfr, ((f32x4){0.f, 0.f, 0.f, 0.f}));
#pragma unroll
        for (int r = 0; r < 4; ++r) { const float z = zz[r] + abv[r];
            const float e = __builtin_amdgcn_exp2f(-fabsf(z) * LOG2E), l2 = __builtin_amdgcn_logf(1.0f + e);
            float x = fmaxf((fminf(z, 0.f) * LOG2E - l2) * 0.0625f, -1.25f * LOG2E);
            x += DPP_ROW_SHR(x, 1); x += DPP_ROW_SHR(x, 2); x += DPP_ROW_SHR(x, 4); x += DPP_ROW_SHR(x, 8);
            b2[tt][r] = x; } }
    float blast[4];
#pragma unroll
    for (int r = 0; r < 4; ++r) { const float t0 = __shfl(b2[0][r], lane | 15), t1 = __shfl(b2[1][r], lane | 15), t2 = __shfl(b2[2][r], lane | 15), t3 = __shfl(b2[3][r], lane | 15);
        b2[1][r] += t0; b2[2][r] += t0 + t1; b2[3][r] += (t0 + t1) + t2; blast[r] = (t0 + t1) + (t2 + t3); }
    if (l15 == 0) *(LAS f32x4*)(lds + G_EBL0 + buf * G_EBLB + (16 * wave + 4 * lg) * 4) = (f32x4){__builtin_amdgcn_exp2f(blast[0]), __builtin_amdgcn_exp2f(blast[1]), __builtin_amdgcn_exp2f(blast[2]), __builtin_amdgcn_exp2f(blast[3])};
#pragma unroll
    for (int tt = 0; tt < 4; ++tt) { const int t = 16 * tt + l15;
        LAS u32x2* qp = (LAS u32x2*)(Qb_ + t * 272 + (16 * wave + 4 * lg) * 2); LAS u32x2* kp = (LAS u32x2*)(Kb_ + t * 272 + (16 * wave + 4 * lg) * 2);
        const u32x2 q2 = *qp, k2 = *kp;
        const float e0 = __builtin_amdgcn_exp2f(b2[tt][0]), e1 = __builtin_amdgcn_exp2f(b2[tt][1]), e2 = __builtin_amdgcn_exp2f(b2[tt][2]), e3 = __builtin_amdgcn_exp2f(b2[tt][3]);
        const float n0 = __builtin_amdgcn_exp2f(-b2[tt][0]), n1 = __builtin_amdgcn_exp2f(-b2[tt][1]), n2 = __builtin_amdgcn_exp2f(-b2[tt][2]), n3 = __builtin_amdgcn_exp2f(-b2[tt][3]);
        *qp = (u32x2){pk2(bf_lo(q2.x) * e0, bf_hi(q2.x) * e1), pk2(bf_lo(q2.y) * e2, bf_hi(q2.y) * e3)};
        const unsigned kw0 = pk2(bf_lo(k2.x) * n0, bf_hi(k2.x) * n1), kw1 = pk2(bf_lo(k2.y) * n2, bf_hi(k2.y) * n3);
        *kp = (u32x2){kw0, kw1};
        LAS unsigned short* kt = (LAS unsigned short*)(KTb + (16 * wave + 4 * lg) * 144 + 2 * t);
        kt[0] = (unsigned short)(kw0 & 0xffffu); kt[72] = (unsigned short)(kw0 >> 16); kt[144] = (unsigned short)(kw1 & 0xffffu); kt[216] = (unsigned short)(kw1 >> 16); }
}
__device__ __forceinline__ void gla_CD(LAS unsigned char* lds, int buf, f32x4 (&st)[8], int wave, int l15, int lg) {
    const LAS unsigned char* Qb_ = lds + G_Q0 + buf * G_QKB; const LAS unsigned char* KTb = lds + G_KT0 + buf * G_KTB;
    bf16x8 av[2], as[4];
#pragma unroll
    for (int ks = 0; ks < 2; ++ks) av[ks] = *(const LAS bf16x8*)(lds + G_VT + (16 * wave + l15) * 144 + (32 * ks + 8 * lg) * 2);
#pragma unroll
    for (int ks = 0; ks < 4; ++ks) { const u32x4 w = (u32x4){pk2(st[2 * ks][0], st[2 * ks][1]), pk2(st[2 * ks][2], st[2 * ks][3]), pk2(st[2 * ks + 1][0], st[2 * ks + 1][1]), pk2(st[2 * ks + 1][2], st[2 * ks + 1][3])};
        as[ks] = __builtin_bit_cast(bf16x8, w); }
#pragma unroll
    for (int tt = 0; tt < 4; ++tt) { f32x4 acc = (f32x4){0.f, 0.f, 0.f, 0.f};
#pragma unroll
        for (int ks = 0; ks < 2; ++ks) { const bf16x8 bp = *(const LAS bf16x8*)(lds + G_P + (16 * tt + l15) * 144 + (32 * ks + 8 * lg) * 2); acc = MFMA16(av[ks], bp, acc); }
#pragma unroll
        for (int ks = 0; ks < 4; ++ks) { const LAS unsigned char* qa = Qb_ + (16 * tt + l15) * 272 + (32 * ks + 4 * lg) * 2;
            const u32x2 lo = *(const LAS u32x2*)qa, hi = *(const LAS u32x2*)(qa + 32);
            acc = MFMA16(as[ks], __builtin_bit_cast(bf16x8, ((u32x4){lo.x, lo.y, hi.x, hi.y})), acc); }
        *(LAS u32x2*)(lds + G_OS + (16 * tt + l15) * 272 + (16 * wave + 4 * lg) * 2) = (u32x2){pk2(acc[0], acc[1]), pk2(acc[2], acc[3])}; }
#pragma unroll
    for (int dt = 0; dt < 8; ++dt) { const f32x4 e4 = *(const LAS f32x4*)(lds + G_EBL0 + buf * G_EBLB + (16 * dt + 4 * lg) * 4);
#pragma unroll
        for (int ks = 0; ks < 2; ++ks) { const bf16x8 a = *(const LAS bf16x8*)(KTb + (16 * dt + l15) * 144 + (32 * ks + 8 * lg) * 2); st[dt] = MFMA16(a, av[ks], st[dt]); }
        st[dt] = st[dt] * e4; }
}
__device__ __forceinline__ void gla_item(LAS unsigned char* lds, const bf16* __restrict__ qb, const bf16* __restrict__ kb, const bf16* __restrict__ vb, const float* __restrict__ rab,
                                         const float* __restrict__ aw_p, const float* __restrict__ ab_p, bf16* __restrict__ ob, int b, int h, int dir, int vh, int tid) {
    const int lane = tid & 63, wave = __builtin_amdgcn_readfirstlane(tid >> 6), l15 = lane & 15, lg = lane >> 4;
    bf16x8 awf;
#pragma unroll
    for (int j = 0; j < 8; ++j) awf[j] = (short)f2bf(aw_p[(8 * (lg & 1) + j) * 512 + h * 128 + 16 * wave + l15]);
    float abv[4];
#pragma unroll
    for (int r = 0; r < 4; ++r) abv[r] = ab_p[h * 128 + 16 * wave + 4 * lg + r];
    f32x4 st[8];
#pragma unroll
    for (int i = 0; i < 8; ++i) st[i] = (f32x4){0.f, 0.f, 0.f, 0.f};
    u32x4 rq[2], rk[2], rv[2]; f32x4 rr = (f32x4){0.f, 0.f, 0.f, 0.f};
    const size_t tokb = (size_t)b * S; const int colbase = h * 256 + vh * 128;
#define GLA_TOK(n, r) (tokb + (size_t)(dir ? (S - 1 - (64 * (n) + (r))) : (64 * (n) + (r))))
#define GLA_LOAD_QK(n) do { \
        _Pragma("unroll") for (int i = 0; i < 2; ++i) { const int p = tid + 512 * i, row = p >> 4, c8 = p & 15; const size_t tok = GLA_TOK(n, row); \
            rq[i] = *(const u32x4*)(qb + tok * 512 + h * 128 + c8 * 8); rk[i] = *(const u32x4*)(kb + tok * 512 + h * 128 + c8 * 8); } \
        if (tid < 256) { const int row = tid >> 2, part = tid & 3; rr = *(const f32x4*)(rab + GLA_TOK(n, row) * 32 + dir * 16 + part * 4); } } while (0)
#define GLA_LOAD_V(n) do { \
        _Pragma("unroll") for (int i = 0; i < 2; ++i) { const int s = tid & 63, c8 = (tid >> 6) + 8 * i; const size_t tok = GLA_TOK(n, s); \
            rv[i] = *(const u32x4*)(vb + tok * 1024 + colbase + c8 * 8); } } while (0)
#define GLA_STORE_QK(buf) do { \
        _Pragma("unroll") for (int i = 0; i < 2; ++i) { const int p = tid + 512 * i, row = p >> 4, c8 = p & 15; \
            *(LAS u32x4*)(lds + G_Q0 + (buf) * G_QKB + row * 272 + c8 * 16) = rq[i]; *(LAS u32x4*)(lds + G_K0 + (buf) * G_QKB + row * 272 + c8 * 16) = rk[i]; } \
        if (tid < 256) { const int row = tid >> 2, part = tid & 3; \
            const unsigned h0 = pk2(rr[0], rr[1]), h1 = pk2(rr[2], rr[3]); \
            const unsigned l0 = pk2(rr[0] - bf_lo(h0), rr[1] - bf_hi(h0)), l1 = pk2(rr[2] - bf_lo(h1), rr[3] - bf_hi(h1)); \
            *(LAS u32x2*)(lds + G_RA + row * 64 + part * 8) = (u32x2){h0, h1}; *(LAS u32x2*)(lds + G_RA + row * 64 + 32 + part * 8) = (u32x2){l0, l1}; } } while (0)
#define GLA_STORE_V() do { \
        _Pragma("unroll") for (int i = 0; i < 2; ++i) { const int s = tid & 63, c8 = (tid >> 6) + 8 * i; LAS unsigned short* vt = (LAS unsigned short*)(lds + G_VT + (c8 * 8) * 144 + 2 * s); \
            vt[0 * 72] = (unsigned short)(rv[i].x & 0xffffu); vt[1 * 72] = (unsigned short)(rv[i].x >> 16); vt[2 * 72] = (unsigned short)(rv[i].y & 0xffffu); vt[3 * 72] = (unsigned short)(rv[i].y >> 16); \
            vt[4 * 72] = (unsigned short)(rv[i].z & 0xffffu); vt[5 * 72] = (unsigned short)(rv[i].z >> 16); vt[6 * 72] = (unsigned short)(rv[i].w & 0xffffu); vt[7 * 72] = (unsigned short)(rv[i].w >> 16); } } while (0)
#define GLA_STORE_O(n) do { \
        _Pragma("unroll") for (int i = 0; i < 2; ++i) { const int p = tid + 512 * i, row = p >> 4, c8 = p & 15; \
            *(u32x4*)(ob + GLA_TOK(n, row) * 1024 + colbase + c8 * 8) = *(const LAS u32x4*)(lds + G_OS + row * 272 + c8 * 16); } } while (0)
    GLA_LOAD_QK(0); GLA_LOAD_V(0);
    GLA_STORE_QK(0); GLA_STORE_V();
    GLA_LOAD_QK(1);
    __syncthreads();
    gla_A(lds, 0, awf, abv, wave, lane, l15, lg);
    __syncthreads();
    for (int n = 0; n < 32; ++n) {
        const int buf = n & 1;
        { const int ti = wave >> 1;
#pragma unroll
          for (int u = 0; u < 2; ++u) { const int si = 2 * (wave & 1) + u; f32x4 acc = (f32x4){0.f, 0.f, 0.f, 0.f};
#pragma unroll
              for (int ks = 0; ks < 4; ++ks) { const bf16x8 a = *(const LAS bf16x8*)(lds + G_K0 + buf * G_QKB + (16 * si + l15) * 272 + (32 * ks + 8 * lg) * 2);
                  const bf16x8 bq = *(const LAS bf16x8*)(lds + G_Q0 + buf * G_QKB + (16 * ti + l15) * 272 + (32 * ks + 8 * lg) * 2); acc = MFMA16(a, bq, acc); }
              const int t = 16 * ti + l15, s0 = 16 * si + 4 * lg; float pv[4];
#pragma unroll
              for (int r = 0; r < 4; ++r) { const int s = s0 + r; const bool keep = dir ? (s < t) : (s <= t); pv[r] = keep ? acc[r] : 0.f; }
              *(LAS u32x2*)(lds + G_P + t * 144 + s0 * 2) = (u32x2){pk2(pv[0], pv[1]), pk2(pv[2], pv[3])}; } }
        if (n > 0) GLA_STORE_O(n - 1);
        if (n + 1 < 32) GLA_STORE_QK(buf ^ 1);
        if (n > 0) GLA_STORE_V();
        __syncthreads();
        if (n + 2 < 32) GLA_LOAD_QK(n + 2);
        if (n + 1 < 32) GLA_LOAD_V(n + 1);
#pragma unroll 1
        for (int ph = 0; ph < 2; ++ph) {
            if ((ph == 0) == (wave < 4)) { if (n + 1 < 32) gla_A(lds, buf ^ 1, awf, abv, wave, lane, l15, lg); }
            else gla_CD(lds, buf, st, wave, l15, lg);
        }
        __syncthreads();
    }
    GLA_STORE_O(31);
    __syncthreads();
#undef GLA_STORE_O
#undef GLA_LOAD_QK
#undef GLA_LOAD_V
#undef GLA_STORE_QK
#undef GLA_STORE_V
#undef GLA_TOK
}

constexpr int M_VN = 0, M_WS = 34816, M_U = 69632, M_MU = 104448, M_RS = 104960;
typedef short v4i16_t __attribute__((ext_vector_type(4)));
__device__ __forceinline__ u32x2 lds_tr16(const LAS unsigned char* p) { return __builtin_bit_cast(u32x2, __builtin_amdgcn_ds_read_tr16_b64_v4i16((LAS v4i16_t*)p)); }
__device__ __forceinline__ void gmlp_item(LAS unsigned char* lds, const bf16* __restrict__ gv, bf16* ug, const float* __restrict__ lng, const float* __restrict__ lnb,
                                          const float* __restrict__ wsp, const float* __restrict__ bsp, int item, int tid) {
    const int lane = tid & 63, wave = __builtin_amdgcn_readfirstlane(tid >> 6), l15 = lane & 15, lg = lane >> 4;
    const size_t T0 = (size_t)(item >> 4) * S + (size_t)(item & 15) * 128;
    LAS float* MU = (LAS float*)(lds + M_MU); LAS float* RS = (LAS float*)(lds + M_RS);
    for (int rr0 = 0; rr0 < 16; rr0 += 8) {
        u32x4 x0[8], x1[8];
#pragma unroll
        for (int u = 0; u < 8; ++u) { const u32x4* p = (const u32x4*)(gv + (T0 + 16 * wave + rr0 + u) * 1024); x0[u] = p[lane]; x1[u] = p[64 + lane]; }
#pragma unroll
        for (int u = 0; u < 8; ++u) { float s = 0.f, s2 = 0.f;
#define ACC2(w) do { const float a_ = bf_lo(w), b_ = bf_hi(w); s += a_ + b_; s2 += a_ * a_ + b_ * b_; } while (0)
            ACC2(x0[u].x); ACC2(x0[u].y); ACC2(x0[u].z); ACC2(x0[u].w); ACC2(x1[u].x); ACC2(x1[u].y); ACC2(x1[u].z); ACC2(x1[u].w);
#undef ACC2
            s = wave_sum(s); s2 = wave_sum(s2);
            const float mu = s * (1.0f / 1024.0f), var = fmaxf(s2 * (1.0f / 1024.0f) - mu * mu, 0.f);
            if (lane == 0) { MU[16 * wave + rr0 + u] = mu; RS[16 * wave + rr0 + u] = 1.0f / sqrtf(var + EPS); } }
    }
    const int c8 = tid & 15, rb = tid >> 4;
    u32x4 raw[4], uraw[4]; f32x4 w4[8];
#define GM_LOAD(g) do { \
        _Pragma("unroll") for (int i = 0; i < 4; ++i) { const size_t off = (T0 + rb + 32 * i) * 1024 + 128 * (g) + 8 * c8; raw[i] = *(const u32x4*)(gv + off); uraw[i] = *(const u32x4*)(ug + off); } \
        _Pragma("unroll") for (int i = 0; i < 8; ++i) { const int p = tid + 512 * i, t = p >> 5, s4 = p & 31; w4[i] = *(const f32x4*)(wsp + ((size_t)(g) * 128 + t) * 128 + 4 * s4); } } while (0)
    GM_LOAD(0);
    __syncthreads();
    for (int g = 0; g < 8; ++g) {
        { const f32x4 g0 = *(const f32x4*)(lng + 128 * g + 8 * c8), g1 = *(const f32x4*)(lng + 128 * g + 8 * c8 + 4), b0 = *(const f32x4*)(lnb + 128 * g + 8 * c8), b1 = *(const f32x4*)(lnb + 128 * g + 8 * c8 + 4);
#pragma unroll
          for (int i = 0; i < 4; ++i) { const int s_ = rb + 32 * i; const float mu = MU[s_], rs = RS[s_];
              const f32x4 v0 = ((f32x4){bf_lo(raw[i].x), bf_hi(raw[i].x), bf_lo(raw[i].y), bf_hi(raw[i].y)} - mu) * rs * g0 + b0;
              const f32x4 v1 = ((f32x4){bf_lo(raw[i].z), bf_hi(raw[i].z), bf_lo(raw[i].w), bf_hi(raw[i].w)} - mu) * rs * g1 + b1;
              *(LAS u32x4*)(lds + M_VN + s_ * 272 + c8 * 16) = (u32x4){pk2(v0[0], v0[1]), pk2(v0[2], v0[3]), pk2(v1[0], v1[1]), pk2(v1[2], v1[3])};
              *(LAS u32x4*)(lds + M_U + s_ * 272 + c8 * 16) = uraw[i]; } }
#pragma unroll
        for (int i = 0; i < 8; ++i) { const int p = tid + 512 * i, t = p >> 5, s4 = p & 31;
            *(LAS u32x2*)(lds + M_WS + t * 272 + 8 * s4) = (u32x2){pk2(w4[i][0], w4[i][1]), pk2(w4[i][2], w4[i][3])}; }
        if (g + 1 < 8) GM_LOAD(g + 1);
        float bias[8];
#pragma unroll
        for (int tt = 0; tt < 8; ++tt) bias[tt] = bsp[g * 128 + 16 * tt + l15];
        __syncthreads();
        bf16x8 a[4];
#pragma unroll
        for (int ks = 0; ks < 4; ++ks) { const LAS unsigned char* ap = lds + M_VN + (32 * ks + 8 * lg + (l15 >> 2)) * 272 + (16 * wave + 4 * (l15 & 3)) * 2;
            const u32x2 lo = lds_tr16(ap), hi = lds_tr16(ap + 4 * 272); a[ks] = __builtin_bit_cast(bf16x8, ((u32x4){lo.x, lo.y, hi.x, hi.y})); }
#pragma unroll
        for (int tt = 0; tt < 8; ++tt) { f32x4 acc = (f32x4){0.f, 0.f, 0.f, 0.f};
#pragma unroll
            for (int ks = 0; ks < 4; ++ks) { const bf16x8 bw = *(const LAS bf16x8*)(lds + M_WS + (16 * tt + l15) * 272 + (32 * ks + 8 * lg) * 2); acc = MFMA16(a[ks], bw, acc); }
            LAS u32x2* up = (LAS u32x2*)(lds + M_U + (16 * tt + l15) * 272 + (16 * wave + 4 * lg) * 2); const u32x2 uu = *up;
            *up = (u32x2){pk2((acc[0] + bias[tt]) * bf_lo(uu.x), (acc[1] + bias[tt]) * bf_hi(uu.x)), pk2((acc[2] + bias[tt]) * bf_lo(uu.y), (acc[3] + bias[tt]) * bf_hi(uu.y))}; }
        __syncthreads();
#pragma unroll
        for (int i = 0; i < 4; ++i) { const int s_ = rb + 32 * i; *(u32x4*)(ug + (T0 + s_) * 1024 + 128 * g + 8 * c8) = *(const LAS u32x4*)(lds + M_U + s_ * 272 + c8 * 16); }
    }
    __syncthreads();
#undef GM_LOAD
}

constexpr int MISC_OFF = LDS_BYTES - 128;
constexpr int CW_BAR = 4096;
constexpr size_t CTL_ZERO_BYTES = 65536;

#define XB_TMO      128
#define XB_XCNT(j)  (256  + 64 * (j))
#define XB_XSUB(j)  (1280 + 64 * (j))
#define XB_XGEN(j)  (2304 + 64 * (j))
#define XB_TOP      3328
#define XB_TOPGEN   3392
#define XCD_BAR_WORDS 3456
#define XB_SPIN_CAP (1u << 18)

__device__ __forceinline__ unsigned xb_ld(unsigned* p)              { return __hip_atomic_load(p, __ATOMIC_RELAXED, __HIP_MEMORY_SCOPE_AGENT); }
__device__ __forceinline__ unsigned xb_add(unsigned* p, unsigned v) { return __hip_atomic_fetch_add(p, v, __ATOMIC_RELAXED, __HIP_MEMORY_SCOPE_AGENT); }
__device__ __forceinline__ unsigned xb_xcc_id() { return (unsigned)__builtin_amdgcn_s_getreg((3 << 11) | 20) & 0xFu; }
#define XB_SPIN(cond, bar) do { unsigned _sp = 0; while (cond) { __builtin_amdgcn_s_sleep(1); \
    if ((++_sp & 255u) == 0u) { if (xb_ld(&(bar)[XB_TMO])) break; if (_sp > XB_SPIN_CAP) { atomicAdd(&(bar)[XB_TMO], 1u); break; } } } } while (0)

struct XcdBarrier {
    unsigned* bar; unsigned x;
    volatile LAS unsigned* st;
};

__device__ __forceinline__ XcdBarrier xcd_barrier_post(unsigned* bar, volatile LAS unsigned* st) {
    XcdBarrier b; b.bar = bar; b.x = xb_xcc_id(); b.st = st;
    if (threadIdx.x == 0) (void)xb_add(&bar[XB_XCNT(b.x)], 1u);
    return b;
}
__device__ __forceinline__ void xcd_barrier_complete(unsigned* bar, unsigned x, unsigned& nloc, unsigned& nx) {
    const unsigned G = gridDim.x * gridDim.y * gridDim.z;
    unsigned sum, cnt, mine, sp = 0u;
    for (;;) {
        sum = 0u; cnt = 0u; mine = 0u;
#pragma unroll
        for (unsigned j = 0; j < 16; ++j) { const unsigned c = xb_ld(&bar[XB_XCNT(j)]); sum += c; cnt += (c > 0u) ? 1u : 0u; mine = (j == x) ? c : mine; }
        if (sum == G) break;
        __builtin_amdgcn_s_sleep(1);
        if ((++sp & 255u) == 0u) { if (xb_ld(&bar[XB_TMO])) break; if (sp > XB_SPIN_CAP) { atomicAdd(&bar[XB_TMO], 1u); break; } }
    }
    nloc = mine > 0u ? mine : 1u; nx = cnt > 0u ? cnt : 1u;
}

__device__ __forceinline__ void xcd_barrier(const XcdBarrier& b) {
    asm volatile("s_waitcnt vmcnt(0)" ::: "memory");
    __syncthreads();
    if (threadIdx.x == 0) {
        unsigned* bar = b.bar;
        __builtin_amdgcn_s_waitcnt(0);
        unsigned nloc = b.st[0], nx = b.st[1];
        if (nloc == 0u) { xcd_barrier_complete(bar, b.x, nloc, nx); b.st[0] = nloc; b.st[1] = nx; }
        const unsigned old = xb_add(&bar[XB_XSUB(b.x)], 1u);
        const unsigned gen = old / nloc;
        if (old + 1u == (gen + 1u) * nloc) {
            __builtin_amdgcn_fence(__ATOMIC_RELEASE, "agent");
            asm volatile("s_waitcnt vmcnt(0)" ::: "memory");
            const unsigned og = xb_add(&bar[XB_TOP], 1u);
            const unsigned tg = og / nx;
            if (og + 1u == (tg + 1u) * nx) xb_add(&bar[XB_TOPGEN], 1u);
            else XB_SPIN(xb_ld(&bar[XB_TOPGEN]) == tg, bar);
            __builtin_amdgcn_fence(__ATOMIC_ACQUIRE, "agent");
            xb_add(&bar[XB_XGEN(b.x)], 1u);
            asm volatile("s_waitcnt vmcnt(0)" ::: "memory");
        } else {
            XB_SPIN(xb_ld(&bar[XB_XGEN(b.x)]) == gen, bar);
            __builtin_amdgcn_fence(__ATOMIC_ACQUIRE, "agent");
            asm volatile("s_waitcnt vmcnt(0)" ::: "memory");
        }
    }
    __syncthreads();
}

#define GRID_SYNC() xcd_barrier(bar)
__global__ void __launch_bounds__(NTHR, 2) fwd_megakernel(Args args) {
    extern __shared__ __attribute__((aligned(16))) unsigned char lds_raw[];
    LAS unsigned char* lds = (LAS unsigned char*)lds_raw;
    if (threadIdx.x < 32) ((LAS unsigned*)(lds + MISC_OFF))[threadIdx.x] = 0u;
    __syncthreads();
    const XcdBarrier bar = xcd_barrier_post((unsigned*)args.ws + CW_BAR, (volatile LAS unsigned*)(lds + MISC_OFF) + 8);
    const int tid = threadIdx.x, lane = tid & 63, wave = __builtin_amdgcn_readfirstlane(tid >> 6);
    const int G = gridDim.x, bx = blockIdx.x;
    const int gw = bx * NWAVES + wave, NGW = G * NWAVES;
    unsigned char* ws = args.ws;
    const float* x = args.in[0]; float* out = args.out;
    float* mod = (float*)(ws + WS_MOD);
    bf16* Win_t = (bf16*)(ws + WS_WIN); bf16* Wg_t = (bf16*)(ws + WS_WG); bf16* Wm_t = (bf16*)(ws + WS_WM); bf16* Wo_t = (bf16*)(ws + WS_WO);
    float* RA = (float*)(ws + WS_RA);
    bf16* Qb = (bf16*)(ws + WS_Q); bf16* Kb = (bf16*)(ws + WS_K); bf16* Vb = (bf16*)(ws + WS_V); bf16* SZ = (bf16*)(ws + WS_SZ); bf16* UG = (bf16*)(ws + WS_UG);
    bf16* GV = (bf16*)(ws + WS_GV); bf16* SMG = (bf16*)(ws + WS_SMG); bf16* SMM = (bf16*)(ws + WS_SMM); bf16* MG = (bf16*)(ws + WS_MG);
    bf16* XN = (bf16*)out; bf16* OFW = (bf16*)out; bf16* OBW = (bf16*)out + (size_t)M * 1024;

    if (bx < 48) p0_mod(lds, args.in[1], args.in[3], args.in[4], mod, bx, tid);
    {
        LAS float* scr = (LAS float*)(lds + wave * 16384);
        constexpr int I_IN = 16 * 264, I_SQ = 16 * 32, NITEMS = I_IN + 3 * I_SQ;
        for (int it = gw; it < NITEMS; it += NGW) {
            int r = it;
            if (r < I_IN) { const int kb = r / 264, db = r % 264, sb = win_src_block(db); transpose_item(args.in[5], NIN_SRC, Win_t, D, 32 * db, sb < 0 ? -1 : 32 * sb, 64 * kb, scr, lane); continue; } r -= I_IN;
            const int w = r / I_SQ; r -= w * I_SQ;
            const float* src = args.in[15 + w]; bf16* dst = w == 0 ? Wg_t : (w == 1 ? Wm_t : Wo_t);
            transpose_item(src, D, dst, D, 32 * (r % 32), 32 * (r % 32), 64 * (r / 32), scr, lane);
        }
    }
    GRID_SYNC();
    {
        const float* ng = args.in[2];
        for (int m0 = gw; m0 < M; m0 += 4 * NGW) {
            f32x4 v[4][4];
#pragma unroll
            for (int u = 0; u < 4; ++u) { if (m0 + u * NGW >= M) break; const f32x4* xr = (const f32x4*)(x + (size_t)(m0 + u * NGW) * D) + lane;
#pragma unroll
                for (int j = 0; j < 4; ++j) v[u][j] = __builtin_nontemporal_load(xr + 64 * j); }
#pragma unroll
            for (int u = 0; u < 4; ++u) { const int m = m0 + u * NGW; if (m >= M) break; const float* mb = mod + (size_t)(m >> 11) * 3072; float ss = 0.f;
#pragma unroll
                for (int j = 0; j < 4; ++j) ss += (v[u][j][0] * v[u][j][0] + v[u][j][1] * v[u][j][1]) + (v[u][j][2] * v[u][j][2] + v[u][j][3] * v[u][j][3]);
                const float r = 1.0f / sqrtf(wave_sum(ss) * (1.0f / D) + EPS);
#pragma unroll
                for (int j = 0; j < 4; ++j) { const int col = 256 * j + 4 * lane; const f32x4 g4 = *(const f32x4*)(ng + col), sc4 = *(const f32x4*)(mb + 1024 + col), sh4 = *(const f32x4*)(mb + col);
                    const f32x4 hv = v[u][j] * r * g4 * (sc4 + 1.0f) + sh4;
                    *(u32x2*)(XN + (size_t)m * D + col) = (u32x2){pk2(hv[0], hv[1]), pk2(hv[2], hv[3])}; } }
        }
    }
    GRID_SYNC();
    {
        pg8::Gemm g{XN, Win_t, M, NINP, D}; pg8::StaticOrder So; So.init(M, NINP, G, bx);
        pg8::EpiIn E{Qb, Kb, Vb, SZ, UG, GV, SMG, SMM, RA};
        pg8::gemm_phase<pg8::EpiIn, pg8::StaticOrder, PG8_ALIGN, PG8_SP2>(lds, g, So, E);
    }
#if REP_P2 > 1
    {
        pg8::Gemm g{XN, Win_t, M, NINP, D}; pg8::StaticOrder So; So.init(M, NINP, G, bx);
        pg8::EpiIn E{Qb, Kb, Vb, SZ, UG, GV, SMG, SMM, RA};
        pg8::gemm_phase<pg8::EpiIn, pg8::StaticOrder, PG8_ALIGN, PG8_SP2>(lds, g, So, E);
    }
#endif
    GRID_SYNC();
    for (int it = bx; it < 256; it += G) {
        const int vh = it & 1, dir = (it >> 1) & 1, h = (it >> 2) & 3, b = it >> 4;
        gla_item(lds, Qb, Kb, Vb, RA, dir ? args.in[8] : args.in[6], dir ? args.in[9] : args.in[7], dir ? OBW : OFW, b, h, dir, vh, tid);
    }
#if REP_GLA > 1
    for (int it = bx; it < 256; it += G) {
        const int vh = it & 1, dir = (it >> 1) & 1, h = (it >> 2) & 3, b = it >> 4;
        gla_item(lds, Qb, Kb, Vb, RA, dir ? args.in[8] : args.in[6], dir ? args.in[9] : args.in[7], dir ? OBW : OFW, b, h, dir, vh, tid);
    }
#endif
    for (int it = bx; it < 256; it += G) gmlp_item(lds, GV, UG, args.in[11], args.in[12], args.in[13], args.in[14], it, tid);
    GRID_SYNC();
    {
        const float* gg = args.in[10];
        const f32x4* gp = (const f32x4*)(gg + 16 * lane); const f32x4 g0 = gp[0], g1 = gp[1], g2 = gp[2], g3 = gp[3];
        const float gs[16] = {g0[0], g0[1], g0[2], g0[3], g1[0], g1[1], g1[2], g1[3], g2[0], g2[1], g2[2], g2[3], g3[0], g3[1], g3[2], g3[3]};
        for (int m0 = gw; m0 < M; m0 += 4 * NGW) {
            u32x4 f0[4], f1[4], b0[4], b1[4], z0[4], z1[4];
#pragma unroll
            for (int u = 0; u < 4; ++u) { const size_t off = (size_t)(m0 + u * NGW) * 1024 + 16 * lane;
                f0[u] = __builtin_nontemporal_load((const u32x4*)(OFW + off)); f1[u] = __builtin_nontemporal_load((const u32x4*)(OFW + off + 8));
                b0[u] = __builtin_nontemporal_load((const u32x4*)(OBW + off)); b1[u] = __builtin_nontemporal_load((const u32x4*)(OBW + off + 8));
                z0[u] = *(const u32x4*)(SZ + off); z1[u] = *(const u32x4*)(SZ + off + 8); }
#pragma unroll
            for (int u = 0; u < 4; ++u) { const size_t off = (size_t)(m0 + u * NGW) * 1024 + 16 * lane;
                float o[16];
#define SUM2(i, fw, bw) o[i] = bf_lo(fw) + bf_lo(bw); o[i + 1] = bf_hi(fw) + bf_hi(bw)
                SUM2(0, f0[u].x, b0[u].x); SUM2(2, f0[u].y, b0[u].y); SUM2(4, f0[u].z, b0[u].z); SUM2(6, f0[u].w, b0[u].w); SUM2(8, f1[u].x, b1[u].x); SUM2(10, f1[u].y, b1[u].y); SUM2(12, f1[u].z, b1[u].z); SUM2(14, f1[u].w, b1[u].w);
#undef SUM2
                float ss = 0.f;
#pragma unroll
                for (int i = 0; i < 16; ++i) ss += o[i] * o[i];
                ss += __shfl_xor(ss, 1); ss += __shfl_xor(ss, 2); ss += __shfl_xor(ss, 4); ss += __shfl_xor(ss, 8);
                const float r = 1.0f / sqrtf(ss * (1.0f / 256.0f) + EPS);
                const unsigned zw[8] = {z0[u].x, z0[u].y, z0[u].z, z0[u].w, z1[u].x, z1[u].y, z1[u].z, z1[u].w};
                unsigned ow[8];
#pragma unroll
                for (int i = 0; i < 8; ++i) ow[i] = pk2(o[2 * i] * r * gs[2 * i] * bf_lo(zw[i]), o[2 * i + 1] * r * gs[2 * i + 1] * bf_hi(zw[i]));
                *(u32x4*)(SZ + off) = (u32x4){ow[0], ow[1], ow[2], ow[3]}; *(u32x4*)(SZ + off + 8) = (u32x4){ow[4], ow[5], ow[6], ow[7]}; }
        }
    }
    GRID_SYNC();
    {
        pg8::StaticOrder So; So.init(M, D, G, bx);
        { pg8::Gemm g{SZ, Wg_t, M, D, D}; pg8::EpiMerge<true> E{SMG, MG}; pg8::gemm_phase<pg8::EpiMerge<true>, pg8::StaticOrder, PG8_ALIGN, PG8_SP2>(lds, g, So, E); }
        { pg8::Gemm g{UG, Wm_t, M, D, D}; pg8::EpiMerge<false> E{SMM, MG}; pg8::gemm_phase<pg8::EpiMerge<false>, pg8::StaticOrder, PG8_ALIGN, PG8_SP2>(lds, g, So, E); }
    }
#if REP_P45 > 1
    {
        pg8::StaticOrder So; So.init(M, D, G, bx);
        { pg8::Gemm g{SZ, Wg_t, M, D, D}; pg8::EpiMerge<true> E{SMG, MG}; pg8::gemm_phase<pg8::EpiMerge<true>, pg8::StaticOrder, PG8_ALIGN, PG8_SP2>(lds, g, So, E); }
        { pg8::Gemm g{UG, Wm_t, M, D, D}; pg8::EpiMerge<false> E{SMM, MG}; pg8::gemm_phase<pg8::EpiMerge<false>, pg8::StaticOrder, PG8_ALIGN, PG8_SP2>(lds, g, So, E); }
    }
#endif
    GRID_SYNC();
    {
        pg8::Gemm g{MG, Wo_t, M, D, D}; pg8::StaticOrder So; So.init(M, D, G, bx);
        pg8::EpiOut E{x, mod + 2048, out};
        pg8::gemm_phase<pg8::EpiOut, pg8::StaticOrder, PG8_ALIGN, PG8_SP2>(lds, g, So, E);
    }
#if REP_P45 > 1
    {
        pg8::Gemm g{MG, Wo_t, M, D, D}; pg8::StaticOrder So; So.init(M, D, G, bx);
        pg8::EpiOut E{x, mod + 2048, out};
        pg8::gemm_phase<pg8::EpiOut, pg8::StaticOrder, PG8_ALIGN, PG8_SP2>(lds, g, So, E);
    }
#endif
    GRID_SYNC();
#ifdef PROBE_SYNC
    GRID_SYNC(); GRID_SYNC(); GRID_SYNC(); GRID_SYNC(); GRID_SYNC(); GRID_SYNC(); GRID_SYNC();
#endif
    {
        const float* fg = args.in[18];
        f32x4 g4[4];
#pragma unroll
        for (int j = 0; j < 4; ++j) g4[j] = *(const f32x4*)(fg + 256 * j + 4 * lane);
        for (int m0 = gw; m0 < M; m0 += 4 * NGW) {
            f32x4 v[4][4];
#pragma unroll
            for (int u = 0; u < 4; ++u) { const f32x4* xr = (const f32x4*)(out + (size_t)(m0 + u * NGW) * D) + lane;
#pragma unroll
                for (int j = 0; j < 4; ++j) v[u][j] = xr[64 * j]; }
#pragma unroll
            for (int u = 0; u < 4; ++u) { f32x4* xr = (f32x4*)(out + (size_t)(m0 + u * NGW) * D) + lane; float ss = 0.f;
#pragma unroll
                for (int j = 0; j < 4; ++j) ss += (v[u][j][0] * v[u][j][0] + v[u][j][1] * v[u][j][1]) + (v[u][j][2] * v[u][j][2] + v[u][j][3] * v[u][j][3]);
                const float r = 1.0f / sqrtf(wave_sum(ss) * (1.0f / D) + EPS);
#pragma unroll
                for (int j = 0; j < 4; ++j) xr[64 * j] = v[u][j] * r * g4[j]; }
        }
    }
}

extern "C" void kernel_launch(void* const* d_in, const int* in_sizes, int n_in, void* d_out, int out_size, void* d_ws, size_t ws_size, hipStream_t stream) {
    static int grid = 0;
    if (grid == 0) {
        if (n_in != 19 || in_sizes[0] != M * D || out_size != M * D || ws_size < WS_END) { fprintf(stderr, "kernel_launch: unexpected shapes (n_in %d, in0 %d, out %d, ws %zu); nothing launched\n", n_in, n_in > 0 ? in_sizes[0] : -1, out_size, ws_size); grid = -1; return; }
        int dev = 0, cus = 0, per_cu = 0;
        if (hipGetDevice(&dev) != hipSuccess || hipDeviceGetAttribute(&cus, hipDeviceAttributeMultiprocessorCount, dev) != hipSuccess) { grid = -1; return; }
        if (hipFuncSetAttribute((const void*)fwd_megakernel, hipFuncAttributeMaxDynamicSharedMemorySize, LDS_BYTES) != hipSuccess) { fprintf(stderr, "kernel_launch: hipFuncSetAttribute failed\n"); grid = -1; return; }
        if (hipOccupancyMaxActiveBlocksPerMultiprocessor(&per_cu, (const void*)fwd_megakernel, NTHR, LDS_BYTES) != hipSuccess || per_cu < 1) { fprintf(stderr, "kernel_launch: occupancy query says %d blocks per CU; nothing launched\n", per_cu); (void)hipGetLastError(); grid = -1; return; }
        grid = cus * (per_cu < 1 ? 1 : 1);
    }
    if (grid < 0) return;
    if (hipMemsetAsync(d_ws, 0, CTL_ZERO_BYTES, stream) != hipSuccess) { fprintf(stderr, "kernel_launch: hipMemsetAsync failed; nothing launched\n"); return; }
    Args a{};
    for (int i = 0; i < 19; ++i) a.in[i] = (const float*)d_in[i];
    a.out = (float*)d_out; a.ws = (unsigned char*)d_ws;
    void* kargs[] = {&a};
    const hipError_t e = hipLaunchCooperativeKernel((const void*)fwd_megakernel, dim3(grid), dim3(NTHR), kargs, LDS_BYTES, stream);
    if (e != hipSuccess) fprintf(stderr, "kernel_launch: cooperative launch failed: %s (grid %d)\n", hipGetErrorString(e), grid);
}
```
